# Optimizing an MI355X kernel written in HIP

```python
import math
import jax, jax.numpy as jnp
from jax import lax
import numpy as np

D_MODEL = 2048
BATCH = 4
SEQ = 4096
DEPTH = 2

DIFF_HEADS = 8
DIFF_HEAD_DIM = 64
DIFF_QK_WIDTH = DIFF_HEADS * 2 * DIFF_HEAD_DIM
DIFF_V_WIDTH = DIFF_HEADS * 2 * DIFF_HEAD_DIM
DIFF_Q_BLOCK = 128
MOBA_HEADS = 8
MOBA_HEAD_DIM = 128
MOBA_WIDTH = MOBA_HEADS * MOBA_HEAD_DIM
MOBA_BLOCK = 256
MOBA_TOPK = 3
MOBA_Q_CHUNK = 32
ROPE_THETA = 500000.0
ROT_FRAC_DIV = 4
D_FF = 5632
N_BRANCHES = 2
IN_WIDTH = 2 * DIFF_QK_WIDTH + DIFF_V_WIDTH + 3 * MOBA_WIDTH + N_BRANCHES * D_MODEL
NORM_EPS = 1e-6
SUBLN_EPS = 1e-5
NEG_INF = -1e30

kernel_name = "hybrid_diffattn_moba_macaron"


def rms_norm(x, g, eps=NORM_EPS):
    xf = x.astype(jnp.float32)
    y = xf * lax.rsqrt(jnp.mean(xf * xf, axis=-1, keepdims=True) + eps)
    return (y * g.astype(jnp.float32)).astype(x.dtype)


def rope_tables(seq, head_dim):
    rot = head_dim // ROT_FRAC_DIV
    inv = jnp.power(ROPE_THETA, -jnp.arange(0, rot, 2, dtype=jnp.float32) / rot)
    ang = jnp.arange(seq, dtype=jnp.float32)[:, None] * inv[None, :]
    return jnp.cos(ang), jnp.sin(ang)


def apply_partial_rope(x, cos, sin):
    half = cos.shape[-1]
    rot = 2 * half
    xr, xp = x[..., :rot], x[..., rot:]
    x1, x2 = xr[..., :half], xr[..., half:]
    shape = (1, cos.shape[0]) + (1,) * (x.ndim - 3) + (half,)
    c = cos.reshape(shape).astype(x.dtype)
    s = sin.reshape(shape).astype(x.dtype)
    return jnp.concatenate([x1 * c - x2 * s, x2 * c + x1 * s, xp], axis=-1)


def swiglu(h, w_gu, w_down):
    gu = h @ w_gu
    g, u = gu[..., :D_FF], gu[..., D_FF:]
    return (jax.nn.silu(g) * u) @ w_down


def diff_attention(q, k, v, lq1, lk1, lq2, lk2, subln_g, lambda_init, cos, sin):
    B, S = q.shape[0], q.shape[1]
    q = apply_partial_rope(q, cos, sin)
    k = apply_partial_rope(k, cos, sin)
    f32 = jnp.float32
    lam = (jnp.exp(jnp.sum(lq1.astype(f32) * lk1.astype(f32)))
           - jnp.exp(jnp.sum(lq2.astype(f32) * lk2.astype(f32))) + lambda_init)
    scale = DIFF_HEAD_DIM ** -0.5
    nq = S // DIFF_Q_BLOCK
    qb = q.reshape(B, nq, DIFF_Q_BLOCK, DIFF_HEADS, 2, DIFF_HEAD_DIM).transpose(1, 0, 2, 3, 4, 5)
    starts = jnp.arange(nq, dtype=jnp.int32) * DIFF_Q_BLOCK
    k_pos = jnp.arange(S, dtype=jnp.int32)

    def block(args):
        q_blk, start = args
        s = jnp.einsum('bqhcd,bkhcd->bhcqk', q_blk, k).astype(f32) * scale
        q_pos = start + jnp.arange(DIFF_Q_BLOCK, dtype=jnp.int32)
        s = jnp.where(k_pos[None, :] <= q_pos[:, None], s, NEG_INF)
        p = jax.nn.softmax(s, axis=-1)
        a = p[:, :, 0] - lam * p[:, :, 1]
        return jnp.einsum('bhqk,bkhe->bqhe', a.astype(v.dtype), v)

    o = lax.map(block, (qb, starts))
    o = o.transpose(1, 0, 2, 3, 4).reshape(B, S, DIFF_HEADS, 2 * DIFF_HEAD_DIM)
    o = rms_norm(o, subln_g, SUBLN_EPS) * (1.0 - lambda_init)
    return o.reshape(B, S, DIFF_V_WIDTH)


def moba_attention(q, k, v, cos, sin):
    B, S, H, hd = q.shape
    f32 = jnp.float32
    q = apply_partial_rope(q, cos, sin).transpose(0, 2, 1, 3)
    k = apply_partial_rope(k, cos, sin).transpose(0, 2, 1, 3)
    v = v.transpose(0, 2, 1, 3)
    nb = -(-S // MOBA_BLOCK)
    s_pad = nb * MOBA_BLOCK
    pad = ((0, 0), (0, 0), (0, s_pad - S), (0, 0))
    kp = jnp.pad(k, pad)
    vp = jnp.pad(v, pad)
    kb = kp.reshape(B, H, nb, MOBA_BLOCK, hd)
    vb = vp.reshape(B, H, nb, MOBA_BLOCK, hd)
    k_mean = jnp.mean(kb.astype(f32), axis=3)
    topk = min(MOBA_TOPK, nb)
    scale = hd ** -0.5
    nc = S // MOBA_Q_CHUNK
    qc = q.reshape(B, H, nc, MOBA_Q_CHUNK, hd).transpose(2, 0, 1, 3, 4)
    starts = jnp.arange(nc, dtype=jnp.int32) * MOBA_Q_CHUNK
    blk_ids = jnp.arange(nb, dtype=jnp.int32)
    b_idx = jnp.arange(B)[:, None, None, None]
    h_idx = jnp.arange(H)[None, :, None, None]

    def chunk(args):
        q_c, start = args
        own = start // MOBA_BLOCK
        q_pos = start + jnp.arange(MOBA_Q_CHUNK, dtype=jnp.int32)
        g = jnp.einsum('bhqd,bhnd->bhqn', q_c.astype(f32), k_mean)
        g = jnp.where(blk_ids < own, g, NEG_INF)
        _, sel = lax.top_k(g, topk)
        valid = sel < own
        k_sel = kb[b_idx, h_idx, sel]
        v_sel = vb[b_idx, h_idx, sel]
        s_sel = jnp.einsum('bhqd,bhqrkd->bhqrk', q_c, k_sel).astype(f32) * scale
        s_sel = jnp.where(valid[..., None], s_sel, NEG_INF)
        k_own = lax.dynamic_slice_in_dim(kp, own * MOBA_BLOCK, MOBA_BLOCK, axis=2)
        v_own = lax.dynamic_slice_in_dim(vp, own * MOBA_BLOCK, MOBA_BLOCK, axis=2)
        s_own = jnp.einsum('bhqd,bhkd->bhqk', q_c, k_own).astype(f32) * scale
        own_pos = own * MOBA_BLOCK + jnp.arange(MOBA_BLOCK, dtype=jnp.int32)
        s_own = jnp.where(own_pos[None, :] <= q_pos[:, None], s_own, NEG_INF)
        s_all = jnp.concatenate(
            [s_own, s_sel.reshape(B, H, MOBA_Q_CHUNK, topk * MOBA_BLOCK)], axis=-1)
        p = jax.nn.softmax(s_all, axis=-1).astype(v.dtype)
        p_own = p[..., :MOBA_BLOCK]
        p_sel = p[..., MOBA_BLOCK:].reshape(B, H, MOBA_Q_CHUNK, topk, MOBA_BLOCK)
        return (jnp.einsum('bhqk,bhkd->bhqd', p_own, v_own)
                + jnp.einsum('bhqrk,bhqrkd->bhqd', p_sel, v_sel))

    o = lax.map(chunk, (qc, starts))
    return o.transpose(1, 0, 3, 2, 4).reshape(B, S, H * hd)


def setup_inputs(seed: int = 0) -> dict:
    key = jax.random.key(seed)
    ks = jax.random.split(key, 24)
    f32 = jnp.float32

    def nrm(k, shape, scale):
        return jax.random.normal(k, shape, f32) * scale

    def gain(k, shape):
        return 1.0 + 0.05 * jax.random.normal(k, shape, f32)

    L = DEPTH
    return {
        'x': jax.random.normal(ks[0], (BATCH, SEQ, D_MODEL), f32),
        'ffn1_pre_g': gain(ks[1], (L, D_MODEL)),
        'ffn1_w_gu': nrm(ks[2], (L, D_MODEL, 2 * D_FF), D_MODEL ** -0.5),
        'ffn1_w_down': nrm(ks[3], (L, D_FF, D_MODEL), D_FF ** -0.5),
        'ffn1_post_g': gain(ks[4], (L, D_MODEL)),
        'mix_pre_g': gain(ks[5], (L, D_MODEL)),
        'w_in': nrm(ks[6], (L, D_MODEL, IN_WIDTH), D_MODEL ** -0.5),
        'diff_lq1': nrm(ks[7], (L, DIFF_HEAD_DIM), 0.1),
        'diff_lk1': nrm(ks[8], (L, DIFF_HEAD_DIM), 0.1),
        'diff_lq2': nrm(ks[9], (L, DIFF_HEAD_DIM), 0.1),
        'diff_lk2': nrm(ks[10], (L, DIFF_HEAD_DIM), 0.1),
        'diff_subln_g': gain(ks[11], (L, 2 * DIFF_HEAD_DIM)),
        'w_branch_diff': nrm(ks[12], (L, DIFF_V_WIDTH, D_MODEL), DIFF_V_WIDTH ** -0.5),
        'w_branch_moba': nrm(ks[13], (L, MOBA_WIDTH, D_MODEL), MOBA_WIDTH ** -0.5),
        'w_out': nrm(ks[14], (L, D_MODEL, D_MODEL), D_MODEL ** -0.5),
        'mix_post_g': gain(ks[15], (L, D_MODEL)),
        'ffn2_pre_g': gain(ks[16], (L, D_MODEL)),
        'ffn2_w_gu': nrm(ks[17], (L, D_MODEL, 2 * D_FF), D_MODEL ** -0.5),
        'ffn2_w_down': nrm(ks[18], (L, D_FF, D_MODEL), D_FF ** -0.5),
        'ffn2_post_g': gain(ks[19], (L, D_MODEL)),
    }


def reference(x, ffn1_pre_g, ffn1_w_gu, ffn1_w_down, ffn1_post_g, mix_pre_g, w_in,
              diff_lq1, diff_lk1, diff_lq2, diff_lk2, diff_subln_g,
              w_branch_diff, w_branch_moba, w_out, mix_post_g,
              ffn2_pre_g, ffn2_w_gu, ffn2_w_down, ffn2_post_g):
    B, S, _ = x.shape
    cos_d, sin_d = rope_tables(S, DIFF_HEAD_DIM)
    cos_m, sin_m = rope_tables(S, MOBA_HEAD_DIM)
    o_qa = 0
    o_ka = o_qa + DIFF_QK_WIDTH
    o_va = o_ka + DIFF_QK_WIDTH
    o_qb = o_va + DIFF_V_WIDTH
    o_kb = o_qb + MOBA_WIDTH
    o_vb = o_kb + MOBA_WIDTH
    o_g = o_vb + MOBA_WIDTH
    for l in range(DEPTH):
        lambda_init = 0.8 - 0.6 * math.exp(-0.3 * l)
        h = rms_norm(x, ffn1_pre_g[l])
        x = x + 0.5 * rms_norm(swiglu(h, ffn1_w_gu[l], ffn1_w_down[l]), ffn1_post_g[l])
        h = rms_norm(x, mix_pre_g[l])
        proj = h @ w_in[l]
        qa = proj[..., o_qa:o_ka].reshape(B, S, DIFF_HEADS, 2, DIFF_HEAD_DIM)
        ka = proj[..., o_ka:o_va].reshape(B, S, DIFF_HEADS, 2, DIFF_HEAD_DIM)
        va = proj[..., o_va:o_qb].reshape(B, S, DIFF_HEADS, 2 * DIFF_HEAD_DIM)
        qm = proj[..., o_qb:o_kb].reshape(B, S, MOBA_HEADS, MOBA_HEAD_DIM)
        km = proj[..., o_kb:o_vb].reshape(B, S, MOBA_HEADS, MOBA_HEAD_DIM)
        vm = proj[..., o_vb:o_g].reshape(B, S, MOBA_HEADS, MOBA_HEAD_DIM)
        gate_a = jax.nn.sigmoid(proj[..., o_g:o_g + D_MODEL])
        gate_b = jax.nn.sigmoid(proj[..., o_g + D_MODEL:o_g + 2 * D_MODEL])
        ya = diff_attention(qa, ka, va, diff_lq1[l], diff_lk1[l], diff_lq2[l], diff_lk2[l],
                            diff_subln_g[l], lambda_init, cos_d, sin_d)
        yb = moba_attention(qm, km, vm, cos_m, sin_m)
        merged = gate_a * (ya @ w_branch_diff[l]) + gate_b * (yb @ w_branch_moba[l])
        x = x + rms_norm(merged @ w_out[l], mix_post_g[l])
        h = rms_norm(x, ffn2_pre_g[l])
        x = x + 0.5 * rms_norm(swiglu(h, ffn2_w_gu[l], ffn2_w_down[l]), ffn2_post_g[l])
    return x
```

```cpp
#include <hip/hip_runtime.h>
#include <hip/hip_cooperative_groups.h>
#include <cstdio>
#include <cstdint>
namespace cg = cooperative_groups;

constexpr int DM = 2048, NB = 4, SEQ = 4096, NL = 2, TOK = NB * SEQ;
constexpr int DFF = 5632, INW = 10240, QKVW = 6144, GW = 4096;
constexpr float LOG2E = 1.4426950408889634f;
namespace pg8 {
#define PG8_LAS __attribute__((address_space(3)))
typedef unsigned short bf16_t;
typedef short bf16x8 __attribute__((ext_vector_type(8)));
typedef float f32x4 __attribute__((ext_vector_type(4)));
typedef unsigned u32x4 __attribute__((ext_vector_type(4)));
constexpr int BM = 256, BK = 64, HALF = 128, HTB = HALF * BK * 2  , STAGE_BYTES = 8 * HTB, NXCD = 8, WGM = 8;

__host__ __device__ __forceinline__ int lds_byte(int r, int c) { const int st = (r >> 4) * 2 + (c >> 5), rr = r & 15, cc = c & 31, ob = rr * 64 + cc * 2; return st * 1024 + (ob ^ (((ob >> 9) & 1) << 5)); }
__host__ __device__ __forceinline__ void stage_rc(int b, int& R, int& C) { const int st = b / 1024, sb = b % 1024, swz = sb ^ (((sb >> 9) & 1) << 5); R = (st >> 1) * 16 + swz / 64; C = (st & 1) * 32 + (swz % 64) / 2; }
__host__ __device__ __forceinline__ int perm32(int rho) { const int n = rho >> 4, i = rho & 15; return 8 * (i >> 2) + 4 * n + (i & 3); }

struct Unit { int pm, pn; };
struct Gemm { const bf16_t* A; const bf16_t* Bt; int M, N, K; };

struct StaticOrder {
    int nM, nN, nwg, G, c;
    __host__ __device__ void init(int M, int N, int G_, int c_) { nM = M / BM; nN = N / BM; nwg = nM * nN; G = G_; c = c_; }
    __host__ __device__ bool next(int i, Unit& u) const {
        const long L = (long)i * G + c; if (L >= nwg) return false;
        int wgid = (int)L; { const int q = nwg / NXCD, r = nwg % NXCD, xcd = wgid % NXCD, off = wgid / NXCD; wgid = (xcd < r ? xcd * (q + 1) : r * (q + 1) + (xcd - r) * q) + off; }
        const int nig = WGM * nN, gid = wgid / nig, fm = gid * WGM, gsz = (nM - fm) < WGM ? (nM - fm) : WGM;
        u.pm = fm + ((wgid % nig) % gsz); u.pn = (wgid % nig) / gsz; return true;
    }
    __device__ __forceinline__ void a_ready(const Unit&) const {}
    __device__ __forceinline__ void done(const Unit&) const {}
};

template <int N_> struct StaticOrderT {
    static constexpr int nM = 64, nN = N_ / BM, nwg = nM * nN, q = nwg / NXCD, nig = WGM * nN;
    static_assert(nwg % NXCD == 0, "nwg must be a multiple of 8");
    int G, c;
    __host__ __device__ void init(int, int, int G_, int c_) { G = G_; c = c_; }
    __host__ __device__ bool next(int i, Unit& u) const {
        const int L = i * G + c; if (L >= nwg) return false;
        const int w = (L % NXCD) * q + L / NXCD;
        const int gid = w / nig, rem = w % nig;
        u.pm = gid * WGM + (rem % WGM); u.pn = rem / WGM; return true;
    }
    __device__ __forceinline__ void a_ready(const Unit&) const {}
    __device__ __forceinline__ void done(const Unit&) const {}
};

typedef float f32x2_cv __attribute__((ext_vector_type(2))); typedef __bf16 bf16x2_cv __attribute__((ext_vector_type(2)));
__device__ __forceinline__ unsigned cvt_pk_bf16(float lo, float hi) { const f32x2_cv v = {lo, hi}; const bf16x2_cv b = __builtin_convertvector(v, bf16x2_cv); return __builtin_bit_cast(unsigned, b); }
typedef unsigned u32x2 __attribute__((ext_vector_type(2)));
__device__ __forceinline__ float bf_lo(unsigned w) { return __uint_as_float(w << 16); }
__device__ __forceinline__ float bf_hi(unsigned w) { return __uint_as_float(w & 0xffff0000u); }
__device__ __forceinline__ float fast_sigmoid(float v) { return __builtin_amdgcn_rcpf(1.0f + __builtin_amdgcn_exp2f(-v * 1.4426950408889634f)); }

struct EpiStore {
    static constexpr bool PERM = true, AFTER_DRAIN = false;
    bf16_t* O; int ldc;
    __device__ __forceinline__ void operator()(const f32x4 (&acc)[2][2][4][2], const Unit& u, int wr, int wc, int fr, int fq) const {
        const int row0 = u.pm * BM + wr * 64 + fr, col0 = u.pn * BM + wc * 32 + 8 * fq;
#pragma unroll
        for (int ai = 0; ai < 2; ++ai)
#pragma unroll
            for (int m = 0; m < 4; ++m) { bf16_t* rowp = O + (size_t)(row0 + ai * HALF + m * 16) * ldc + col0;
#pragma unroll
                for (int bj = 0; bj < 2; ++bj) { const f32x4 v0 = acc[ai][bj][m][0], v1 = acc[ai][bj][m][1];
                    u32x4 w; w.x = cvt_pk_bf16(v0[0], v0[1]); w.y = cvt_pk_bf16(v0[2], v0[3]); w.z = cvt_pk_bf16(v1[0], v1[1]); w.w = cvt_pk_bf16(v1[2], v1[3]);
                    *(u32x4*)(rowp + bj * HALF) = w; } }
    }
};
struct EpiSwiglu {
    static constexpr bool PERM = true, AFTER_DRAIN = false;
    bf16_t* O; int ldc; const float* rstd;
    __device__ __forceinline__ void operator()(const f32x4 (&acc)[2][2][4][2], const Unit& u, int wr, int wc, int fr, int fq) const {
        const int row0 = u.pm * BM + wr * 64 + fr, col0 = u.pn * HALF + wc * 32 + 8 * fq;
#pragma unroll
        for (int ai = 0; ai < 2; ++ai)
#pragma unroll
            for (int m = 0; m < 4; ++m) { bf16_t* rowp = O + (size_t)(row0 + ai * HALF + m * 16) * ldc + col0;
                const float rs_ = rstd[row0 + ai * HALF + m * 16];
                float r[8];
#pragma unroll
                for (int n = 0; n < 2; ++n)
#pragma unroll
                    for (int j = 0; j < 4; ++j) { const float g = acc[ai][0][m][n][j] * rs_, up = acc[ai][1][m][n][j] * rs_; r[n * 4 + j] = g * up * fast_sigmoid(g); }
                u32x4 w; w.x = cvt_pk_bf16(r[0], r[1]); w.y = cvt_pk_bf16(r[2], r[3]); w.z = cvt_pk_bf16(r[4], r[5]); w.w = cvt_pk_bf16(r[6], r[7]);
                *(u32x4*)rowp = w; }
    }
};
struct EpiProj {
    static constexpr bool PERM = true, AFTER_DRAIN = false;
    bf16_t* QKV; bf16_t* G; const float* csd; const float* csm;
    const float* rstd; bf16_t* VT; float* kmean;
    __device__ __forceinline__ void operator()(const f32x4 (&acc)[2][2][4][2], const Unit& u, int wr, int wc, int fr, int fq) const {
        const int colt = u.pn * BM;
        const int row0 = u.pm * BM + wr * 64 + fr;
        const int region = colt < 2048 ? 0 : colt < 3072 ? 1 : colt < 5120 ? 2 : colt < 6144 ? 1 : 3;
        const float qs = colt < 1024 ? 0.125f * LOG2E : (colt >= 3072 && colt < 4096) ? 0.08838834764831845f * LOG2E : 1.0f;
        const bool kmt = colt >= 4096 && colt < 5120;
        float ksum[2][8];
#pragma unroll
        for (int bj = 0; bj < 2; ++bj)
#pragma unroll
            for (int e = 0; e < 8; ++e) ksum[bj][e] = 0.f;
#pragma unroll
        for (int ai = 0; ai < 2; ++ai)
#pragma unroll
            for (int m = 0; m < 4; ++m) {
                const int row = row0 + ai * HALF + m * 16; const int pos = row & (SEQ - 1);
                const float rs_ = rstd[row];
#pragma unroll
                for (int bj = 0; bj < 2; ++bj) {
                    float v[8];
#pragma unroll
                    for (int n = 0; n < 2; ++n)
#pragma unroll
                        for (int j = 0; j < 4; ++j) v[n * 4 + j] = acc[ai][bj][m][n][j] * rs_;
                    if (region == 0) {
                        if ((wc & 1) == 0) {
                            float pr[8];
#pragma unroll
                            for (int e = 0; e < 8; ++e) pr[e] = __shfl_xor(v[e], 16);
                            if (fq < 2) {
                                const f32x4* cp = (const f32x4*)(csd + pos * 16);
                                const f32x4 c0 = cp[0], c1 = cp[1], s0 = cp[2], s1 = cp[3];
                                const float cs[8] = {c0[0], c0[1], c0[2], c0[3], c1[0], c1[1], c1[2], c1[3]};
                                const float sn[8] = {s0[0], s0[1], s0[2], s0[3], s1[0], s1[1], s1[2], s1[3]};
                                const float sg = fq == 0 ? -1.f : 1.f;
#pragma unroll
                                for (int e = 0; e < 8; ++e) v[e] = v[e] * cs[e] + sg * pr[e] * sn[e];
                            }
                        }
#pragma unroll
                        for (int e = 0; e < 8; ++e) v[e] *= qs;
                    } else if (region == 2) {
                        if (wc == 0) {
                            float pr[8];
#pragma unroll
                            for (int e = 0; e < 8; ++e) pr[e] = __shfl_xor(v[e], 32);
                            const f32x4* cp = (const f32x4*)(csm + pos * 32 + (fq & 1) * 8);
                            const f32x4 c0 = cp[0], c1 = cp[1], s0 = cp[4], s1 = cp[5];
                            const float cs[8] = {c0[0], c0[1], c0[2], c0[3], c1[0], c1[1], c1[2], c1[3]};
                            const float sn[8] = {s0[0], s0[1], s0[2], s0[3], s1[0], s1[1], s1[2], s1[3]};
                            const float sg = fq < 2 ? -1.f : 1.f;
#pragma unroll
                            for (int e = 0; e < 8; ++e) v[e] = v[e] * cs[e] + sg * pr[e] * sn[e];
                        }
#pragma unroll
                        for (int e = 0; e < 8; ++e) v[e] *= qs;
                        if (kmt) {
#pragma unroll
                            for (int e = 0; e < 8; ++e) ksum[bj][e] += v[e];
                        }
                    } else if (region == 3) {
#pragma unroll
                        for (int e = 0; e < 8; ++e) v[e] = fast_sigmoid(v[e]);
                    }
                    if (region == 1) {
                        const int vt = colt >= 5120 ? 1 : 0, head = ((colt - (vt ? 5120 : 2048)) >> 7) + bj;
                        const bool odd = fr & 1;
                        bf16_t* vb = VT + ((size_t)((vt * 32 + (row >> 12) * 8 + head) * 128 + wc * 32 + 8 * fq + (odd ? 4 : 0)) * SEQ + (pos & ~1));
#pragma unroll
                        for (int i = 0; i < 4; ++i) {
                            const float snd = odd ? v[i] : v[4 + i];
                            const float rcv = __shfl_xor(snd, 1);
                            const unsigned w2 = odd ? cvt_pk_bf16(rcv, v[4 + i]) : cvt_pk_bf16(v[i], rcv);
                            *(unsigned*)(vb + (size_t)i * SEQ) = w2;
                        }
                    } else {
                    u32x4 w; w.x = cvt_pk_bf16(v[0], v[1]); w.y = cvt_pk_bf16(v[2], v[3]); w.z = cvt_pk_bf16(v[4], v[5]); w.w = cvt_pk_bf16(v[6], v[7]);
                    const int col = colt + bj * HALF + wc * 32 + 8 * fq;
                    bf16_t* dst = (region == 3) ? (G + (size_t)row * GW + (col - QKVW)) : (QKV + (size_t)row * QKVW + col);
                    *(u32x4*)dst = w;
                    }
                }
            }
        if (kmt) {
#pragma unroll
            for (int bj = 0; bj < 2; ++bj)
#pragma unroll
                for (int e = 0; e < 8; ++e) { float t = ksum[bj][e]; t += __shfl_xor(t, 1); t += __shfl_xor(t, 2); t += __shfl_xor(t, 4); t += __shfl_xor(t, 8); ksum[bj][e] = t; }
            if (fr == 0) {
                const int bb = u.pm >> 4, blk = u.pm & 15;
#pragma unroll
                for (int bj = 0; bj < 2; ++bj) { const int head = ((colt - 4096) >> 7) + bj;
                    float* kp = kmean + (size_t)((bb * 8 + head) * 16 + blk) * 128 + wc * 32 + 8 * fq;
#pragma unroll
                    for (int e = 0; e < 8; ++e) atomicAdd(kp + e, ksum[bj][e] * (1.0f / 256.0f)); }
            }
        }
    }
};
template <bool ADD> struct EpiGate {
    static constexpr bool PERM = true, AFTER_DRAIN = false;
    bf16_t* O; const bf16_t* G; int gcol0;
    __device__ __forceinline__ void operator()(const f32x4 (&acc)[2][2][4][2], const Unit& u, int wr, int wc, int fr, int fq) const {
        const int row0 = u.pm * BM + wr * 64 + fr, col0 = u.pn * BM + wc * 32 + 8 * fq;
#pragma unroll
        for (int ai = 0; ai < 2; ++ai)
#pragma unroll
            for (int m = 0; m < 4; ++m) { const int row = row0 + ai * HALF + m * 16;
#pragma unroll
                for (int bj = 0; bj < 2; ++bj) { const int col = col0 + bj * HALF;
                    const u32x4 g = *(const u32x4*)(G + (size_t)row * GW + gcol0 + col);
                    float r[8];
                    r[0] = acc[ai][bj][m][0][0] * bf_lo(g.x); r[1] = acc[ai][bj][m][0][1] * bf_hi(g.x); r[2] = acc[ai][bj][m][0][2] * bf_lo(g.y); r[3] = acc[ai][bj][m][0][3] * bf_hi(g.y);
                    r[4] = acc[ai][bj][m][1][0] * bf_lo(g.z); r[5] = acc[ai][bj][m][1][1] * bf_hi(g.z); r[6] = acc[ai][bj][m][1][2] * bf_lo(g.w); r[7] = acc[ai][bj][m][1][3] * bf_hi(g.w);
                    bf16_t* dst = O + (size_t)row * DM + col;
                    if (ADD) { const u32x4 o = *(const u32x4*)dst;
                        r[0] += bf_lo(o.x); r[1] += bf_hi(o.x); r[2] += bf_lo(o.y); r[3] += bf_hi(o.y); r[4] += bf_lo(o.z); r[5] += bf_hi(o.z); r[6] += bf_lo(o.w); r[7] += bf_hi(o.w); }
                    u32x4 w; w.x = cvt_pk_bf16(r[0], r[1]); w.y = cvt_pk_bf16(r[2], r[3]); w.z = cvt_pk_bf16(r[4], r[5]); w.w = cvt_pk_bf16(r[6], r[7]);
                    *(u32x4*)dst = w; } }
    }
};

struct BranchOrder {
    StaticOrderT<2048> base;
    __host__ __device__ void init(int G_, int c_) { base.init(0, 0, G_, c_); }
    __host__ __device__ bool next(int i, Unit& u) const { if (!base.next(i >> 1, u)) return false; if (i & 1) { u.pm += 64; u.pn += 8; } return true; }
    __device__ __forceinline__ void a_ready(const Unit&) const {}
    __device__ __forceinline__ void done(const Unit&) const {}
};
struct EpiGate2 {
    static constexpr bool PERM = true, AFTER_DRAIN = false;
    bf16_t* O; const bf16_t* G;
    __device__ __forceinline__ void operator()(const f32x4 (&acc)[2][2][4][2], const Unit& u, int wr, int wc, int fr, int fq) const {
        const bool add = u.pm >= 64;
        const int row0 = (u.pm & 63) * BM + wr * 64 + fr, col0 = (u.pn & 7) * BM + wc * 32 + 8 * fq, gcol0 = add ? 2048 : 0;
#pragma unroll
        for (int ai = 0; ai < 2; ++ai)
#pragma unroll
            for (int m = 0; m < 4; ++m) { const int row = row0 + ai * HALF + m * 16;
#pragma unroll
                for (int bj = 0; bj < 2; ++bj) { const int col = col0 + bj * HALF;
                    const u32x4 g = *(const u32x4*)(G + (size_t)row * GW + gcol0 + col);
                    float r[8];
                    r[0] = acc[ai][bj][m][0][0] * bf_lo(g.x); r[1] = acc[ai][bj][m][0][1] * bf_hi(g.x); r[2] = acc[ai][bj][m][0][2] * bf_lo(g.y); r[3] = acc[ai][bj][m][0][3] * bf_hi(g.y);
                    r[4] = acc[ai][bj][m][1][0] * bf_lo(g.z); r[5] = acc[ai][bj][m][1][1] * bf_hi(g.z); r[6] = acc[ai][bj][m][1][2] * bf_lo(g.w); r[7] = acc[ai][bj][m][1][3] * bf_hi(g.w);
                    bf16_t* dst = O + (size_t)row * DM + col;
                    if (add) { const u32x4 o = *(const u32x4*)dst;
                        r[0] += bf_lo(o.x); r[1] += bf_hi(o.x); r[2] += bf_lo(o.y); r[3] += bf_hi(o.y); r[4] += bf_lo(o.z); r[5] += bf_hi(o.z); r[6] += bf_lo(o.w); r[7] += bf_hi(o.w); }
                    u32x4 w; w.x = cvt_pk_bf16(r[0], r[1]); w.y = cvt_pk_bf16(r[2], r[3]); w.z = cvt_pk_bf16(r[4], r[5]); w.w = cvt_pk_bf16(r[6], r[7]);
                    *(u32x4*)dst = w; } }
    }
};

template <class Epi, class Sched, bool ALIGN_EPI = false, bool SP2 = false>
__device__ __forceinline__ void gemm_phase(PG8_LAS unsigned char* lds, const Gemm g, const Sched& S, const Epi& E) {
    int tid_ = threadIdx.x; asm volatile("" : "+v"(tid_));
    const int tid = tid_, wid = __builtin_amdgcn_readfirstlane(tid >> 6), lane = tid & 63, wr = wid >> 2, wc = wid & 3, fr = lane & 15, fq = lane >> 4;
    const int K = g.K, nt = K / BK;
    unsigned voffA[2], voffB[2];
#pragma unroll
    for (int i = 0; i < 2; ++i) { int R, C; stage_rc(tid * 16 + i * 8192, R, C); const int Rb = Epi::PERM ? ((R & ~31) + perm32(R & 31)) : R;
        voffA[i] = (unsigned)(R * K + C) * 2u; voffB[i] = (unsigned)(Rb * K + C) * 2u; }
    const size_t kstep = (size_t)(BK * 2);
    const size_t hstep = (size_t)HALF * K * 2;
    const size_t tstep = 2 * hstep;
    const unsigned ldsw = (unsigned)wid * 1024u;
    const int aoff = lds_byte(wr * 64 + fr, fq * 8), boff = lds_byte(wc * 32 + fr, fq * 8);
#define PG8_SA(b, h) (((b) * 2 + (h)) * HTB)
#define PG8_SB(b, h) ((4 + (b) * 2 + (h)) * HTB)
#define PG8_STAGE(bufoff, gbase, voff) do { _Pragma("unroll") for (int _i = 0; _i < 2; ++_i) \
        __builtin_amdgcn_global_load_lds((const unsigned*)((const char*)(gbase) + (voff)[_i]), (PG8_LAS unsigned*)(lds + (bufoff) + ldsw + _i * 8192), 16, 0, 0); } while (0)
#define PG8_LDA(dst, b, h) do { _Pragma("unroll") for (int m = 0; m < 4; ++m) _Pragma("unroll") for (int k = 0; k < 2; ++k) dst[m][k] = *(const PG8_LAS bf16x8*)(lds + PG8_SA(b, h) + aoff + m * 2048 + k * 1024); } while (0)
#define PG8_LDB(dst, b, h) do { _Pragma("unroll") for (int n = 0; n < 2; ++n) _Pragma("unroll") for (int k = 0; k < 2; ++k) dst[n][k] = *(const PG8_LAS bf16x8*)(lds + PG8_SB(b, h) + boff + n * 2048 + k * 1024); } while (0)
#define PG8_MMA(ai, bj, At, Bt) do { __builtin_amdgcn_s_setprio(1); _Pragma("unroll") for (int m = 0; m < 4; ++m) _Pragma("unroll") for (int n = 0; n < 2; ++n) _Pragma("unroll") for (int k = 0; k < 2; ++k) \
        acc[ai][bj][m][n] = __builtin_amdgcn_mfma_f32_16x16x32_bf16(Bt[n][k], At[m][k], acc[ai][bj][m][n], 0, 0, 0); __builtin_amdgcn_s_setprio(0); } while (0)
#define PG8_WAIT_V(n) asm volatile("s_waitcnt vmcnt(" #n ")" ::: "memory")
#define PG8_WAIT_L(n) asm volatile("s_waitcnt lgkmcnt(" #n ")" ::: "memory")
#define PG8_BAR __builtin_amdgcn_s_barrier()
#define PG8_SCHED __builtin_amdgcn_sched_barrier(0)
    Unit cur, nxt; int ui = 0;
    if (!S.next(0, cur)) return;
    f32x4 acc[2][2][4][2];
#pragma unroll
    for (int a = 0; a < 2; ++a)
#pragma unroll
        for (int b = 0; b < 2; ++b)
#pragma unroll
            for (int m = 0; m < 4; ++m)
#pragma unroll
                for (int n = 0; n < 2; ++n) acc[a][b][m][n] = (f32x4){0.f, 0.f, 0.f, 0.f};
    bf16x8 At[4][2], B0[2][2], B1[2][2];
    const char* cA = (const char*)g.A + (size_t)cur.pm * tstep; const char* cB = (const char*)g.Bt + (size_t)cur.pn * tstep;
    S.a_ready(cur);
    if constexpr (SP2) {
        PG8_STAGE(PG8_SB(0, 0), cB, voffB); PG8_STAGE(PG8_SB(0, 1), cB + hstep, voffB); PG8_STAGE(PG8_SA(0, 0), cA, voffA); PG8_STAGE(PG8_SA(0, 1), cA + hstep, voffA);
        if (wr == 1) PG8_BAR;
        PG8_WAIT_V(2); PG8_BAR;
        PG8_STAGE(PG8_SB(1, 0), cB + kstep, voffB); PG8_STAGE(PG8_SA(1, 0), cA + kstep, voffA); PG8_STAGE(PG8_SB(1, 1), cB + hstep + kstep, voffB);
        PG8_WAIT_V(6); PG8_BAR;
    } else {
        PG8_STAGE(PG8_SB(0, 0), cB, voffB); PG8_STAGE(PG8_SA(0, 0), cA, voffA); PG8_STAGE(PG8_SB(0, 1), cB + hstep, voffB); PG8_STAGE(PG8_SA(0, 1), cA + hstep, voffA);
        if (wr == 1) PG8_BAR;
        PG8_WAIT_V(4); PG8_BAR;
        PG8_STAGE(PG8_SB(1, 0), cB + kstep, voffB); PG8_STAGE(PG8_SA(1, 0), cA + kstep, voffA); PG8_STAGE(PG8_SB(1, 1), cB + hstep + kstep, voffB);
        PG8_WAIT_V(6); PG8_BAR;
    }
    for (;;) {
        const bool has_next = S.next(ui + 1, nxt);
        const char* nA = has_next ? (const char*)g.A + (size_t)nxt.pm * tstep : cA; const char* nB = has_next ? (const char*)g.Bt + (size_t)nxt.pn * tstep : cB;
        for (int t = 0; t < nt; t += 2) {
            const bool last = (t == nt - 2);
            const char* a1 = cA + (size_t)(t + 1) * kstep;
            const char* a2 = last ? nA : cA + (size_t)(t + 2) * kstep; const char* b2 = last ? nB : cB + (size_t)(t + 2) * kstep;
            const char* a3 = a2 + kstep; const char* b3 = b2 + kstep;
            if (last && has_next) S.a_ready(nxt);
            if constexpr (SP2) {
            PG8_LDB(B0, 0, 0); PG8_LDB(B1, 0, 1); PG8_SCHED; PG8_LDA(At, 0, 0); PG8_STAGE(PG8_SA(1, 1), a1 + hstep, voffA);
            PG8_WAIT_V(8); PG8_WAIT_L(0); PG8_BAR; PG8_MMA(0, 0, At, B0); PG8_MMA(0, 1, At, B1); PG8_BAR; PG8_SCHED;
            PG8_LDA(At, 0, 1); PG8_STAGE(PG8_SB(0, 0), b2, voffB); PG8_STAGE(PG8_SB(0, 1), b2 + hstep, voffB); PG8_STAGE(PG8_SA(0, 0), a2, voffA);
            PG8_WAIT_V(8); PG8_WAIT_L(0); PG8_BAR; PG8_MMA(1, 0, At, B0); PG8_MMA(1, 1, At, B1); PG8_BAR; PG8_SCHED;
            PG8_LDB(B0, 1, 0); PG8_LDB(B1, 1, 1); PG8_SCHED; PG8_LDA(At, 1, 0); PG8_STAGE(PG8_SA(0, 1), a2 + hstep, voffA);
            PG8_WAIT_V(8); PG8_WAIT_L(0); PG8_BAR; PG8_MMA(0, 0, At, B0); PG8_MMA(0, 1, At, B1); PG8_BAR; PG8_SCHED;
            PG8_LDA(At, 1, 1); PG8_STAGE(PG8_SB(1, 0), b3, voffB); PG8_STAGE(PG8_SB(1, 1), b3 + hstep, voffB); PG8_STAGE(PG8_SA(1, 0), a3, voffA);
            PG8_WAIT_V(8); PG8_WAIT_L(0); PG8_BAR; PG8_MMA(1, 0, At, B0); PG8_MMA(1, 1, At, B1); PG8_BAR; PG8_SCHED;
            } else {
            PG8_LDB(B0, 0, 0); PG8_SCHED; PG8_LDA(At, 0, 0); PG8_STAGE(PG8_SA(1, 1), a1 + hstep, voffA);
            PG8_WAIT_L(8); PG8_BAR; PG8_WAIT_L(0); PG8_MMA(0, 0, At, B0); PG8_BAR; PG8_SCHED;
            PG8_LDB(B1, 0, 1); PG8_STAGE(PG8_SB(0, 0), b2, voffB);
            PG8_BAR; PG8_WAIT_L(0); PG8_MMA(0, 1, At, B1); PG8_BAR;
            PG8_LDA(At, 0, 1); PG8_STAGE(PG8_SA(0, 0), a2, voffA);
            PG8_BAR; PG8_WAIT_L(0); PG8_MMA(1, 0, At, B0); PG8_BAR; PG8_SCHED;
            PG8_STAGE(PG8_SB(0, 1), b2 + hstep, voffB);
            PG8_WAIT_V(6); PG8_BAR; PG8_MMA(1, 1, At, B1); PG8_BAR;
            PG8_LDB(B0, 1, 0); PG8_SCHED; PG8_LDA(At, 1, 0); PG8_STAGE(PG8_SA(0, 1), a2 + hstep, voffA);
            PG8_WAIT_L(8); PG8_BAR; PG8_WAIT_L(0); PG8_MMA(0, 0, At, B0); PG8_BAR; PG8_SCHED;
            PG8_LDB(B1, 1, 1); PG8_STAGE(PG8_SB(1, 0), b3, voffB);
            PG8_BAR; PG8_WAIT_L(0); PG8_MMA(0, 1, At, B1); PG8_BAR;
            PG8_LDA(At, 1, 1); PG8_STAGE(PG8_SA(1, 0), a3, voffA);
            PG8_BAR; PG8_WAIT_L(0); PG8_MMA(1, 0, At, B0); PG8_BAR; PG8_SCHED;
            PG8_STAGE(PG8_SB(1, 1), b3 + hstep, voffB);
            PG8_WAIT_V(6); PG8_BAR; PG8_MMA(1, 1, At, B1); PG8_BAR;
            }
        }
        if constexpr (ALIGN_EPI) { if (wr == 0) PG8_BAR; }
        if constexpr (!Epi::AFTER_DRAIN) { E(acc, cur, wr, wc, fr, fq); S.done(cur); }
        if (!has_next) break;
#pragma unroll
        for (int a = 0; a < 2; ++a)
#pragma unroll
            for (int b = 0; b < 2; ++b)
#pragma unroll
                for (int m = 0; m < 4; ++m)
#pragma unroll
                    for (int n = 0; n < 2; ++n) acc[a][b][m][n] = (f32x4){0.f, 0.f, 0.f, 0.f};
        cur = nxt; cA = nA; cB = nB; ++ui;
        if constexpr (ALIGN_EPI) { if (wr == 1) PG8_BAR; }
    }
    PG8_WAIT_V(0);
    if constexpr (!ALIGN_EPI) { if (wr == 0) PG8_BAR; }
    PG8_BAR;
    if constexpr (Epi::AFTER_DRAIN) { E.fused(acc, cur, wr, wc, fr, fq, lds, wid, lane); S.done(cur); }
#undef PG8_SA
#undef PG8_SB
#undef PG8_STAGE
#undef PG8_LDA
#undef PG8_LDB
#undef PG8_MMA
#undef PG8_WAIT_V
#undef PG8_WAIT_L
#undef PG8_BAR
#undef PG8_SCHED
}
}
namespace att {
#define LAS __attribute__((address_space(3)))
typedef unsigned short bf16_t;
typedef short bf16x8 __attribute__((ext_vector_type(8)));
typedef short s16x4 __attribute__((ext_vector_type(4)));
typedef float f32x16 __attribute__((ext_vector_type(16)));
typedef float f32x4 __attribute__((ext_vector_type(4)));
typedef unsigned u32x4 __attribute__((ext_vector_type(4)));
typedef unsigned u32x2 __attribute__((ext_vector_type(2)));
typedef float f32x2 __attribute__((ext_vector_type(2)));
constexpr int KP = 272, VP = 144, KBYTES = 64 * KP, VBYTES = 128 * VP, VRING = 2 * KBYTES, STAGE_ALL = 2 * KBYTES + 3 * VBYTES;
constexpr int OFF_SC = STAGE_ALL;
constexpr int OFF_KM = OFF_SC + 16384;
constexpr int OFF_RM = OFF_KM + 8192;
constexpr int OFF_TL = OFF_RM + 1024;
constexpr float NEG = -1e30f;
__device__ __forceinline__ int crow(int r, int hi) { return (r & 3) + 8 * (r >> 2) + 4 * hi; }
typedef __bf16 bf16x2_cv __attribute__((ext_vector_type(2)));
__device__ __forceinline__ unsigned pk2(float lo, float hi) { const f32x2 v = {lo, hi}; const bf16x2_cv b = __builtin_convertvector(v, bf16x2_cv); return __builtin_bit_cast(unsigned, b); }
__device__ __forceinline__ bf16x8 pack8(const f32x16& p, int b) {
    u32x4 w; w.x = pk2(p[b], p[b + 1]); w.y = pk2(p[b + 2], p[b + 3]); w.z = pk2(p[b + 4], p[b + 5]); w.w = pk2(p[b + 6], p[b + 7]);
    return __builtin_bit_cast(bf16x8, w);
}

template <int MODE>
__device__ __forceinline__ void attn_unit(LAS unsigned char* lds, const bf16_t* __restrict__ QKV, const bf16_t* __restrict__ VT, const float* __restrict__ kmean,
                                          bf16_t* __restrict__ Y, int b, int h, int qb, float lam, float oscale, const float* __restrict__ subg) {
    int tid_ = threadIdx.x; asm volatile("" : "+v"(tid_));
    const int tid = tid_, lane = tid & 63, r32 = lane & 31, hi = lane >> 5;
    const int wid = __builtin_amdgcn_readfirstlane(tid >> 6);
    constexpr int QROWS = MODE ? 256 : 128, NDK = MODE ? 8 : 4;
    const int slab = MODE ? wid : (wid >> 1), cmap = MODE ? 0 : (wid & 1);
    const int q0 = qb * QROWS, qpos = q0 + slab * 32 + r32;
    const size_t tokbase = (size_t)b * SEQ;
    const int qcol = MODE ? (3072 + h * 128) : (h * 128 + cmap * 64);
    const int kcol = MODE ? (4096 + h * 128) : (1024 + h * 128);
    const int koff = MODE ? 0 : cmap * 64;
    const bf16_t* VTb = VT + (size_t)(MODE * 32 + b * 8 + h) * 128 * SEQ;
    LAS int* tl = (LAS int*)(lds + OFF_TL);
    unsigned mymask = 0; int ntiles;
    if (MODE == 1) {
        LAS float* km = (LAS float*)(lds + OFF_KM); LAS float* sc = (LAS float*)(lds + OFF_SC); LAS unsigned* rm = (LAS unsigned*)(lds + OFF_RM);
        ((LAS f32x4*)km)[tid] = ((const f32x4*)(kmean + (size_t)(b * 8 + h) * 16 * 128))[tid];
        if (tid == 0) tl[65] = 0;
        __syncthreads();
        {
            const int q = tid >> 1, part = tid & 1;
            float a[8];
#pragma unroll
            for (int j = 0; j < 8; ++j) a[j] = 0.f;
            const bf16_t* qrow = QKV + (tokbase + q0 + q) * QKVW + qcol;
#pragma unroll 1
            for (int dc = 0; dc < 8; ++dc) {
                const u32x4 w0 = *(const u32x4*)(qrow + dc * 16), w1 = *(const u32x4*)(qrow + dc * 16 + 8);
                const float qv[16] = {__uint_as_float(w0.x << 16), __uint_as_float(w0.x & 0xffff0000u), __uint_as_float(w0.y << 16), __uint_as_float(w0.y & 0xffff0000u),
                                      __uint_as_float(w0.z << 16), __uint_as_float(w0.z & 0xffff0000u), __uint_as_float(w0.w << 16), __uint_as_float(w0.w & 0xffff0000u),
                                      __uint_as_float(w1.x << 16), __uint_as_float(w1.x & 0xffff0000u), __uint_as_float(w1.y << 16), __uint_as_float(w1.y & 0xffff0000u),
                                      __uint_as_float(w1.z << 16), __uint_as_float(w1.z & 0xffff0000u), __uint_as_float(w1.w << 16), __uint_as_float(w1.w & 0xffff0000u)};
#pragma unroll
                for (int j = 0; j < 8; ++j) {
                    const LAS f32x4* kp = (const LAS f32x4*)(km + (part * 8 + j) * 128 + dc * 16);
#pragma unroll
                    for (int d4 = 0; d4 < 4; ++d4) { const f32x4 kk = kp[d4]; a[j] += qv[d4 * 4] * kk[0] + qv[d4 * 4 + 1] * kk[1] + qv[d4 * 4 + 2] * kk[2] + qv[d4 * 4 + 3] * kk[3]; }
                }
            }
#pragma unroll
            for (int j = 0; j < 8; ++j) sc[q * 16 + part * 8 + j] = a[j];
        }
        __syncthreads();
        if (tid < 256) {
            unsigned msk = 0;
            const int nsel = qb < 3 ? qb : 3;
            for (int s = 0; s < nsel; ++s) {
                float best = -3.0e38f; int bi = 0;
                for (int j = 0; j < qb; ++j) { const float v = sc[tid * 16 + j]; if (!((msk >> j) & 1u) && v > best) { best = v; bi = j; } }
                msk |= 1u << bi;
            }
            rm[tid] = msk;
            if (msk) __hip_atomic_fetch_or((LAS unsigned*)&tl[65], msk, __ATOMIC_RELAXED, __HIP_MEMORY_SCOPE_WORKGROUP);
        }
        __syncthreads();
        if (tid == 0) {
            const unsigned um = (unsigned)tl[65]; int n = 0;
            for (int i = 0; i < 4; ++i) tl[n++] = qb * 4 + i;
            for (int j = 0; j < qb; ++j) if ((um >> j) & 1u) for (int i = 0; i < 4; ++i) tl[n++] = j * 4 + i;
            tl[64] = n;
        }
        __syncthreads();
        mymask = rm[slab * 32 + r32];
        ntiles = tl[64];
    } else {
        ntiles = 2 * qb + 2;
    }
    bf16x8 qf[NDK];
    { const bf16_t* qp = QKV + (tokbase + qpos) * QKVW + qcol + hi * 8;
#pragma unroll
      for (int dk = 0; dk < NDK; ++dk) qf[dk] = *(const bf16x8*)(qp + dk * 16); }
    float m = NEG, l = 0.f;
    f32x16 o[4];
#pragma unroll
    for (int i = 0; i < 4; ++i)
#pragma unroll
        for (int r = 0; r < 16; ++r) o[i][r] = 0.f;
    u32x4 kr0, kr1, vr0, vr1;
    const int idA = tid, idB = tid + 512;
    const bf16_t* kg0 = QKV + (tokbase + (idA >> 4)) * QKVW + kcol + (idA & 15) * 8;
    const bf16_t* kg1 = QKV + (tokbase + (idB >> 4)) * QKVW + kcol + (idB & 15) * 8;
    const bf16_t* vg0 = VTb + (size_t)(idA >> 3) * SEQ + (idA & 7) * 8;
    const bf16_t* vg1 = VTb + (size_t)(idB >> 3) * SEQ + (idB & 7) * 8;
    const int kl0 = (idA >> 4) * KP + (idA & 15) * 16, kl1 = (idB >> 4) * KP + (idB & 15) * 16;
    const int vl0 = VRING + (idA >> 3) * VP + ((idA & 7) >> 1) * 32 + (idA & 1) * 8, vl1 = VRING + (idB >> 3) * VP + ((idB & 7) >> 1) * 32 + (idB & 1) * 8;
#define TILE_AT(i) (MODE ? tl[(i)] : (i))
#define GLOAD(K0, K1, V0, V1, kvt) do { const size_t ko_ = (size_t)(kvt) * 64 * QKVW; const int vo_ = (kvt) * 64; \
        K0 = *(const u32x4*)(kg0 + ko_); K1 = *(const u32x4*)(kg1 + ko_); V0 = *(const u32x4*)(vg0 + vo_); V1 = *(const u32x4*)(vg1 + vo_); } while (0)
#define LSTORE(K0, K1, V0, V1, kso, vso) do { LAS unsigned char* kb_ = lds + (kso); LAS unsigned char* vb_ = lds + (vso); \
        *(LAS u32x4*)(kb_ + kl0) = K0; *(LAS u32x4*)(kb_ + kl1) = K1; \
        *(LAS u32x2*)(vb_ + vl0) = (u32x2){V0.x, V0.y}; *(LAS u32x2*)(vb_ + vl0 + 16) = (u32x2){V0.z, V0.w}; \
        *(LAS u32x2*)(vb_ + vl1) = (u32x2){V1.x, V1.y}; *(LAS u32x2*)(vb_ + vl1 + 16) = (u32x2){V1.z, V1.w}; } while (0)
#define TILE_BARRIER() do { asm volatile("s_waitcnt lgkmcnt(0)" ::: "memory"); __builtin_amdgcn_s_barrier(); asm volatile("" ::: "memory"); } while (0)
#define MX3(a, b, c) __builtin_fmaxf(__builtin_fmaxf((a), (b)), (c))
#define SCHED_FENCE() __builtin_amdgcn_sched_barrier(0)
#define QK_TILE(kvt, kslot) do { \
        const int kv0 = (kvt) * 64; const int qlo = q0 + slab * 32; bool needmask; lval = true; \
        if (MODE == 0 || ((kvt) >> 2) == qb) { act = kv0 <= qlo + 31; needmask = kv0 + 63 > qlo; } \
        else { lval = (mymask >> ((kvt) >> 2)) & 1u; act = __any(lval); needmask = false; } \
        if (act) { \
            const LAS unsigned char* ka = lds + (kslot) + r32 * KP + (koff + hi * 8) * 2; \
            const f32x16 zz = {0.f, 0.f, 0.f, 0.f, 0.f, 0.f, 0.f, 0.f, 0.f, 0.f, 0.f, 0.f, 0.f, 0.f, 0.f, 0.f}; \
            bf16x8 kf[4]; \
            _Pragma("unroll") for (int d0 = 0; d0 < NDK; d0 += 4) { \
                _Pragma("unroll") for (int dk = 0; dk < 4; ++dk) kf[dk] = *(const LAS bf16x8*)(ka + (d0 + dk) * 32); \
                SCHED_FENCE(); \
                if (d0 == 0) p0 = __builtin_amdgcn_mfma_f32_32x32x16_bf16(kf[0], qf[0], zz, 0, 0, 0); else p0 = __builtin_amdgcn_mfma_f32_32x32x16_bf16(kf[0], qf[d0], p0, 0, 0, 0); \
                _Pragma("unroll") for (int dk = 1; dk < 4; ++dk) p0 = __builtin_amdgcn_mfma_f32_32x32x16_bf16(kf[dk], qf[d0 + dk], p0, 0, 0, 0); \
                SCHED_FENCE(); } \
            _Pragma("unroll") for (int d0 = 0; d0 < NDK; d0 += 4) { \
                _Pragma("unroll") for (int dk = 0; dk < 4; ++dk) kf[dk] = *(const LAS bf16x8*)(ka + 32 * KP + (d0 + dk) * 32); \
                SCHED_FENCE(); \
                if (d0 == 0) p1 = __builtin_amdgcn_mfma_f32_32x32x16_bf16(kf[0], qf[0], zz, 0, 0, 0); else p1 = __builtin_amdgcn_mfma_f32_32x32x16_bf16(kf[0], qf[d0], p1, 0, 0, 0); \
                _Pragma("unroll") for (int dk = 1; dk < 4; ++dk) p1 = __builtin_amdgcn_mfma_f32_32x32x16_bf16(kf[dk], qf[d0 + dk], p1, 0, 0, 0); \
                SCHED_FENCE(); } \
            SCHED_FENCE(); \
            if (needmask) { \
                asm volatile("" ::: "memory"); \
                _Pragma("unroll") for (int r = 0; r < 16; ++r) { const int kv = kv0 + crow(r, hi); if (kv > qpos) p0[r] = NEG; if (kv + 32 > qpos) p1[r] = NEG; } \
            } \
        } } while (0)
#define SOFTMAX_HALF(P, PA, PB) do { \
            float mx = MX3(P[0], P[1], P[2]); mx = MX3(mx, P[3], P[4]); mx = MX3(mx, P[5], P[6]); mx = MX3(mx, P[7], P[8]); \
            mx = MX3(mx, P[9], P[10]); mx = MX3(mx, P[11], P[12]); mx = MX3(mx, P[13], P[14]); mx = __builtin_fmaxf(mx, P[15]); \
            { auto rr_ = __builtin_amdgcn_permlane32_swap(__float_as_uint(mx), __float_as_uint(mx), false, false); mx = __builtin_fmaxf(__uint_as_float(rr_[0]), __uint_as_float(rr_[1])); } \
            if (MODE == 1 && !lval) mx = NEG; \
            const float mn = __builtin_fmaxf(m, mx); \
            if (__any(mn > m + 8.0f)) { const float alpha = __builtin_amdgcn_exp2f(m - mn); m = mn; l *= alpha; \
                _Pragma("unroll") for (int bl = 0; bl < 4; ++bl) o[bl] = o[bl] * alpha; } \
            const float ms = (MODE == 1 && !lval) ? 1e30f : m; \
            f32x2 s2 = {0.f, 0.f}; \
            _Pragma("unroll") for (int r = 0; r < 16; r += 2) { f32x2 t = {P[r], P[r + 1]}; t = t - (f32x2){ms, ms}; t.x = __builtin_amdgcn_exp2f(t.x); t.y = __builtin_amdgcn_exp2f(t.y); s2 = s2 + t; P[r] = t.x; P[r + 1] = t.y; } \
            l += s2.x + s2.y; \
            PA = pack8(P, 0); PB = pack8(P, 8); \
        } while (0)
#define SOFTMAX_FULL(P, Q, PA0, PB0, PA1, PB1) do { \
            float mx = MX3(P[0], P[1], P[2]); mx = MX3(mx, P[3], P[4]); mx = MX3(mx, P[5], P[6]); mx = MX3(mx, P[7], P[8]); \
            mx = MX3(mx, P[9], P[10]); mx = MX3(mx, P[11], P[12]); mx = MX3(mx, P[13], P[14]); mx = MX3(mx, P[15], Q[0]); \
            mx = MX3(mx, Q[1], Q[2]); mx = MX3(mx, Q[3], Q[4]); mx = MX3(mx, Q[5], Q[6]); mx = MX3(mx, Q[7], Q[8]); \
            mx = MX3(mx, Q[9], Q[10]); mx = MX3(mx, Q[11], Q[12]); mx = MX3(mx, Q[13], Q[14]); mx = __builtin_fmaxf(mx, Q[15]); \
            { auto rr_ = __builtin_amdgcn_permlane32_swap(__float_as_uint(mx), __float_as_uint(mx), false, false); mx = __builtin_fmaxf(__uint_as_float(rr_[0]), __uint_as_float(rr_[1])); } \
            if (MODE == 1 && !lval) mx = NEG; \
            const float mn = __builtin_fmaxf(m, mx); \
            if (__any(mn > m + 8.0f)) { const float alpha = __builtin_amdgcn_exp2f(m - mn); m = mn; l *= alpha; \
                _Pragma("unroll") for (int bl = 0; bl < 4; ++bl) o[bl] = o[bl] * alpha; } \
            const float ms = (MODE == 1 && !lval) ? 1e30f : m; \
            f32x2 s2 = {0.f, 0.f}; \
            _Pragma("unroll") for (int r = 0; r < 16; r += 2) { f32x2 t = {P[r], P[r + 1]}; t = t - (f32x2){ms, ms}; t.x = __builtin_amdgcn_exp2f(t.x); t.y = __builtin_amdgcn_exp2f(t.y); s2 = s2 + t; P[r] = t.x; P[r + 1] = t.y; } \
            PA0 = pack8(P, 0); PB0 = pack8(P, 8); \
            _Pragma("unroll") for (int r = 0; r < 16; r += 2) { f32x2 t = {Q[r], Q[r + 1]}; t = t - (f32x2){ms, ms}; t.x = __builtin_amdgcn_exp2f(t.x); t.y = __builtin_amdgcn_exp2f(t.y); s2 = s2 + t; Q[r] = t.x; Q[r + 1] = t.y; } \
            l += s2.x + s2.y; \
            PA1 = pack8(Q, 0); PB1 = pack8(Q, 8); \
        } while (0)
#define PV_HALF(vso, J0, PA, PB) do { \
            const LAS unsigned char* va = lds + (vso) + VRING + r32 * VP + hi * 16; bf16x8 vf[4]; \
            _Pragma("unroll") for (int b0 = 0; b0 < 4; b0 += 2) { \
                _Pragma("unroll") for (int bl = 0; bl < 2; ++bl) { vf[2 * bl] = *(const LAS bf16x8*)(va + (b0 + bl) * 32 * VP + (J0) * 32); vf[2 * bl + 1] = *(const LAS bf16x8*)(va + (b0 + bl) * 32 * VP + (J0) * 32 + 32); } \
                SCHED_FENCE(); \
                _Pragma("unroll") for (int bl = 0; bl < 2; ++bl) o[b0 + bl] = __builtin_amdgcn_mfma_f32_32x32x16_bf16(vf[2 * bl], PA, o[b0 + bl], 0, 0, 0); \
                _Pragma("unroll") for (int bl = 0; bl < 2; ++bl) o[b0 + bl] = __builtin_amdgcn_mfma_f32_32x32x16_bf16(vf[2 * bl + 1], PB, o[b0 + bl], 0, 0, 0); \
                SCHED_FENCE(); } \
        } while (0)
    const bool trailing = wid >= 4;
    bf16x8 pa0, pb0, pa1, pb1; bool actp = false; int vsp = 0;
#define STEP_LEAD(kvt, kslot, vso) do { f32x16 p0, p1; bool act, lval; \
            QK_TILE(kvt, kslot); \
            if (act) { SOFTMAX_HALF(p0, pa0, pb0); PV_HALF(vso, 0, pa0, pb0); SOFTMAX_HALF(p1, pa1, pb1); PV_HALF(vso, 2, pa1, pb1); } \
        } while (0)
#define STEP_TRAIL(kvt, kslot, vso) do { f32x16 p0, p1; bool act, lval; \
            if (actp) { PV_HALF(vsp, 0, pa0, pb0); PV_HALF(vsp, 2, pa1, pb1); } \
            QK_TILE(kvt, kslot); \
            if (act) { SOFTMAX_FULL(p0, p1, pa0, pb0, pa1, pb1); } \
            actp = act; vsp = (vso); \
        } while (0)
#define TILE_LOOP(STEP) do { \
    int vso = 0, kso = 0; \
    _Pragma("unroll 1") \
    for (int i = 0; i < ntiles; ++i) { \
          const int kvt = TILE_AT(i); \
          LSTORE(kr0, kr1, vr0, vr1, kso, vso); \
          TILE_BARRIER(); \
          GLOAD(kr0, kr1, vr0, vr1, TILE_AT(i + 1 < ntiles ? i + 1 : ntiles - 1)); \
          STEP(kvt, kso, vso); \
          kso ^= KBYTES; vso = (vso == 2 * VBYTES) ? 0 : vso + VBYTES; \
    } } while (0)
    GLOAD(kr0, kr1, vr0, vr1, TILE_AT(0));
    if (trailing) {
        TILE_LOOP(STEP_TRAIL);
        if (actp) { PV_HALF(vsp, 0, pa0, pb0); PV_HALF(vsp, 2, pa1, pb1); }
    } else {
        TILE_LOOP(STEP_LEAD);
    }
#undef TILE_LOOP
#undef STEP_LEAD
#undef STEP_TRAIL
#undef PV_HALF
#undef SOFTMAX_HALF
#undef SOFTMAX_FULL
#undef QK_TILE
#undef SCHED_FENCE
#undef MX3
#undef TILE_BARRIER
#undef TILE_AT
#undef GLOAD
#undef LSTORE
    l += __shfl_xor(l, 32);
    const float inv = 1.0f / l;
    if (MODE == 1) {
        bf16_t* yp = Y + (tokbase + qpos) * 1024 + h * 128 + 4 * hi;
#pragma unroll
        for (int bl = 0; bl < 4; ++bl)
#pragma unroll
            for (int g = 0; g < 4; ++g) {
                u32x2 w; w.x = pk2(o[bl][4 * g] * inv, o[bl][4 * g + 1] * inv); w.y = pk2(o[bl][4 * g + 2] * inv, o[bl][4 * g + 3] * inv);
                *(u32x2*)(yp + bl * 32 + 8 * g) = w;
            }
        __syncthreads();
    } else {
        __syncthreads();
        LAS float* cb = (LAS float*)lds + (slab * 32 + r32) * 132 + 4 * hi;
        if (cmap == 1) {
#pragma unroll
            for (int bl = 0; bl < 4; ++bl)
#pragma unroll
                for (int g = 0; g < 4; ++g)
                    *(LAS f32x4*)(cb + bl * 32 + 8 * g) = (f32x4){o[bl][4 * g] * inv, o[bl][4 * g + 1] * inv, o[bl][4 * g + 2] * inv, o[bl][4 * g + 3] * inv};
        }
        __syncthreads();
        if (cmap == 0) {
            float ss = 0.f;
#pragma unroll
            for (int bl = 0; bl < 4; ++bl)
#pragma unroll
                for (int g = 0; g < 4; ++g) {
                    const f32x4 o2 = *(const LAS f32x4*)(cb + bl * 32 + 8 * g);
#pragma unroll
                    for (int e = 0; e < 4; ++e) { const float v = o[bl][4 * g + e] * inv - lam * o2[e]; o[bl][4 * g + e] = v; ss += v * v; }
                }
            ss += __shfl_xor(ss, 32);
            const float rs = rsqrtf(ss * (1.0f / 128.0f) + 1e-5f) * oscale;
            bf16_t* yp = Y + (tokbase + qpos) * 1024 + h * 128 + 4 * hi;
#pragma unroll
            for (int bl = 0; bl < 4; ++bl)
#pragma unroll
                for (int g = 0; g < 4; ++g) {
                    const f32x4 gg = *(const f32x4*)(subg + bl * 32 + 8 * g + 4 * hi);
                    u32x2 w; w.x = pk2(o[bl][4 * g] * rs * gg[0], o[bl][4 * g + 1] * rs * gg[1]); w.y = pk2(o[bl][4 * g + 2] * rs * gg[2], o[bl][4 * g + 3] * rs * gg[3]);
                    *(u32x2*)(yp + bl * 32 + 8 * g) = w;
                }
        }
        __syncthreads();
    }
}
#undef LAS
}

#define LAS __attribute__((address_space(3)))
typedef unsigned short bf16;
typedef unsigned v4u __attribute__((ext_vector_type(4)));
typedef unsigned v2u __attribute__((ext_vector_type(2)));
typedef float f32x4 __attribute__((ext_vector_type(4)));
constexpr int NWAVES = 8, NTHR = 512;
constexpr int LDS_BYTES = 147456;
constexpr size_t MiB = 1u << 20;
constexpr size_t WS_BAR = 65536;
constexpr int LDS_BARST = 131072 + 64;
constexpr size_t WS_RSTD = 3 * MiB;
constexpr size_t WS_CSD = 1 * MiB, WS_CSM = WS_CSD + 4096 * 16 * 4, WS_KMEAN = 2 * MiB;
constexpr size_t WS_WGU1 = 4 * MiB, WS_WDN1 = 48 * MiB, WS_WGU2 = 70 * MiB, WS_WDN2 = 114 * MiB, WS_WIN = 136 * MiB, WS_WBD = 176 * MiB, WS_WBM = 180 * MiB, WS_WO = 184 * MiB;
constexpr size_t WS_H = 192 * MiB, WS_YZ = 256 * MiB, WS_R1 = 320 * MiB  , WS_GATE = WS_R1 + 192 * MiB;
constexpr size_t WS_VT = 640 * MiB, WS_MRG = 704 * MiB, WS_YA = 768 * MiB, WS_YB = 800 * MiB, WS_END = 832 * MiB;

struct Params { const float* in[20]; float* out; unsigned char* ws; int ph_lo, ph_hi; };
enum { I_X = 0, I_F1PRE, I_F1GU, I_F1DN, I_F1POST, I_MIXPRE, I_WIN, I_LQ1, I_LK1, I_LQ2, I_LK2, I_SUBG, I_WBD, I_WBM, I_WO, I_MIXPOST, I_F2PRE, I_F2GU, I_F2DN, I_F2POST };

__device__ __forceinline__ unsigned f2bf(float f) { unsigned u = __builtin_bit_cast(unsigned, f); return (u + 0x7fffu + ((u >> 16) & 1u)) >> 16; }
__device__ __forceinline__ unsigned pk2(float lo, float hi) { return f2bf(lo) | (f2bf(hi) << 16); }
__device__ __forceinline__ float wave_sum(float v) {
#pragma unroll
    for (int o = 1; o < 64; o <<= 1) v += __shfl_xor(v, o);
    return v;
}
struct ConvItem { const float* W; bf16* WT; int K, N, item, gu; const float* gf; };
__device__ __forceinline__ void conv_load(const ConvItem& c, float (&wv)[32], int lane) {
    const int nblk = c.N / 32, kb = c.item / nblk, nb = c.item % nblk, k0 = 64 * kb, n0 = 32 * nb;
    const float* p = c.W + (size_t)(k0 + (lane >> 5)) * c.N + n0 + (lane & 31);
#pragma unroll
    for (int i = 0; i < 32; ++i) wv[i] = __builtin_nontemporal_load(p + (size_t)(2 * i) * c.N);
    if (c.gf) { const float* gp = c.gf + k0 + (lane >> 5);
#pragma unroll
        for (int i = 0; i < 32; ++i) wv[i] *= gp[2 * i]; }
}
__device__ __forceinline__ void conv_store(const ConvItem& c, const float (&wv)[32], LAS float* scr, int lane) {
    const int nblk = c.N / 32, kb = c.item / nblk, nb = c.item % nblk, k0 = 64 * kb, n0 = 32 * nb;
    int r0 = n0;
    if (c.gu) { const int up = n0 >= DFF ? 1 : 0, nn = n0 - up * DFF; r0 = (nn >> 7) * 256 + up * 128 + (nn & 127); }
#pragma unroll
    for (int i = 0; i < 32; ++i) scr[(2 * i + (lane >> 5)) * 33 + (lane & 31)] = wv[i];
    asm volatile("s_waitcnt lgkmcnt(0)" ::: "memory");
    const int cc = lane & 7;
#pragma unroll
    for (int j = 0; j < 4; ++j) { const int n = (lane >> 3) + 8 * j; const LAS float* sp = scr + (8 * cc) * 33 + n;
        v4u o; o.x = pk2(sp[0 * 33], sp[1 * 33]); o.y = pk2(sp[2 * 33], sp[3 * 33]); o.z = pk2(sp[4 * 33], sp[5 * 33]); o.w = pk2(sp[6 * 33], sp[7 * 33]);
        *(v4u*)(c.WT + (size_t)(r0 + n) * c.K + k0 + 8 * cc) = o; }
    asm volatile("s_waitcnt lgkmcnt(0)" ::: "memory");
}
typedef const __attribute__((address_space(4))) Params* KP;
__device__ __forceinline__ ConvItem conv_item(KP Pp, int layer, int it) {
    unsigned char* ws = Pp->ws;
    constexpr int I_GU = (DM / 64) * (2 * DFF / 32), I_DN = (DFF / 64) * (DM / 32), I_IN = (DM / 64) * (INW / 32), I_BR = (1024 / 64) * (DM / 32);
    const size_t lgu = (size_t)layer * DM * 2 * DFF, ldn = (size_t)layer * DFF * DM;
    int r = it;
    if (r < I_GU) return ConvItem{Pp->in[I_F1GU] + lgu, (bf16*)(ws + WS_WGU1), DM, 2 * DFF, r, 1, Pp->in[I_F1PRE] + layer * DM}; r -= I_GU;
    if (r < I_GU) return ConvItem{Pp->in[I_F2GU] + lgu, (bf16*)(ws + WS_WGU2), DM, 2 * DFF, r, 1, Pp->in[I_F2PRE] + layer * DM}; r -= I_GU;
    if (r < I_DN) return ConvItem{Pp->in[I_F1DN] + ldn, (bf16*)(ws + WS_WDN1), DFF, DM, r, 0, nullptr}; r -= I_DN;
    if (r < I_DN) return ConvItem{Pp->in[I_F2DN] + ldn, (bf16*)(ws + WS_WDN2), DFF, DM, r, 0, nullptr}; r -= I_DN;
    if (r < I_IN) return ConvItem{Pp->in[I_WIN] + (size_t)layer * DM * INW, (bf16*)(ws + WS_WIN), DM, INW, r, 0, Pp->in[I_MIXPRE] + layer * DM}; r -= I_IN;
    if (r < I_BR) return ConvItem{Pp->in[I_WBD] + (size_t)layer * 1024 * DM, (bf16*)(ws + WS_WBD), 1024, DM, r, 0, nullptr}; r -= I_BR;
    if (r < I_BR) return ConvItem{Pp->in[I_WBM] + (size_t)layer * 1024 * DM, (bf16*)(ws + WS_WBM), 1024, DM, r, 0, nullptr}; r -= I_BR;
    return ConvItem{Pp->in[I_WO] + (size_t)layer * DM * DM, (bf16*)(ws + WS_WO), DM, DM, r, 0, nullptr};
}
__device__ __forceinline__ void convert_weights(KP Pp, int layer, LAS unsigned char* lds, int gw, int ngw, int wave, int lane) {
    LAS float* scr = (LAS float*)(lds + wave * 16384);
    constexpr int I_GU = (DM / 64) * (2 * DFF / 32), I_DN = (DFF / 64) * (DM / 32), I_IN = (DM / 64) * (INW / 32), I_BR = (1024 / 64) * (DM / 32), I_OUT = (DM / 64) * (DM / 32);
    constexpr int NIT = 2 * I_GU + 2 * I_DN + I_IN + 2 * I_BR + I_OUT;
    for (int it = gw; it < NIT; it += 2 * ngw) {
        const bool two = it + ngw < NIT;
        const ConvItem a = conv_item(Pp, layer, it), b = conv_item(Pp, layer, two ? it + ngw : it);
        float wa[32], wb[32];
        conv_load(a, wa, lane); conv_load(b, wb, lane);
        conv_store(a, wa, scr, lane);
        if (two) conv_store(b, wb, scr, lane);
    }
}
template <bool XIN_BF, bool XOUT_BF>
__device__ __forceinline__ void ew_rows(const void* xsrc, void* xdst, bf16* xb2, const bf16* y, float scale, const float* gpost, float* rout, int gw, int ngw, int lane) {
    constexpr int NR = XIN_BF ? 4 : 2;
    for (int row0 = gw; row0 < TOK; row0 += NR * ngw) {
        v2u xb[XIN_BF ? NR : 1][8]; f32x4 xf[XIN_BF ? 1 : NR][8]; v2u yb[NR][8];
#pragma unroll
        for (int r = 0; r < NR; ++r) { const int row = (row0 + r * ngw < TOK) ? row0 + r * ngw : row0;
            if (XIN_BF) { const v2u* xr = (const v2u*)((const bf16*)xsrc + (size_t)row * DM) + lane;
#pragma unroll
                for (int j = 0; j < 8; ++j) xb[XIN_BF ? r : 0][j] = xr[64 * j];
            } else { const f32x4* xr = (const f32x4*)((const float*)xsrc + (size_t)row * DM) + lane;
#pragma unroll
                for (int j = 0; j < 8; ++j) xf[XIN_BF ? 0 : r][j] = xr[64 * j]; }
            if (y) { const v2u* yr = (const v2u*)(y + (size_t)row * DM) + lane;
#pragma unroll
                for (int j = 0; j < 8; ++j) yb[r][j] = yr[64 * j]; }
        }
        asm volatile("" ::: "memory");
#pragma unroll
        for (int r = 0; r < NR; ++r) { const int row = row0 + r * ngw; if (row >= TOK) break;
            f32x4 xv[8];
#pragma unroll
            for (int j = 0; j < 8; ++j) { if (XIN_BF) { const v2u w = xb[XIN_BF ? r : 0][j]; xv[j] = (f32x4){__uint_as_float(w.x << 16), __uint_as_float(w.x & 0xffff0000u), __uint_as_float(w.y << 16), __uint_as_float(w.y & 0xffff0000u)}; } else xv[j] = xf[XIN_BF ? 0 : r][j]; }
            if (y) {
                f32x4 yv[8]; float ss = 0.f;
#pragma unroll
                for (int j = 0; j < 8; ++j) { const v2u w = yb[r][j]; yv[j] = (f32x4){__uint_as_float(w.x << 16), __uint_as_float(w.x & 0xffff0000u), __uint_as_float(w.y << 16), __uint_as_float(w.y & 0xffff0000u)};
                    ss += (yv[j].x * yv[j].x + yv[j].y * yv[j].y) + (yv[j].z * yv[j].z + yv[j].w * yv[j].w); }
                const float rs = rsqrtf(wave_sum(ss) * (1.0f / DM) + 1e-6f) * scale;
#pragma unroll
                for (int j = 0; j < 8; ++j) { const f32x4 g = ((const f32x4*)gpost)[lane + 64 * j]; xv[j] = xv[j] + yv[j] * g * rs; }
            }
            if (xdst) {
                if (XOUT_BF) { v2u* xo = (v2u*)((bf16*)xdst + (size_t)row * DM) + lane;
#pragma unroll
                    for (int j = 0; j < 8; ++j) xo[64 * j] = (v2u){pk2(xv[j].x, xv[j].y), pk2(xv[j].z, xv[j].w)};
                } else { f32x4* xo = (f32x4*)((float*)xdst + (size_t)row * DM) + lane;
#pragma unroll
                    for (int j = 0; j < 8; ++j) xo[64 * j] = xv[j]; }
            }
            if (xb2) { v2u* xo = (v2u*)(xb2 + (size_t)row * DM) + lane;
#pragma unroll
                for (int j = 0; j < 8; ++j) xo[64 * j] = (v2u){pk2(xv[j].x, xv[j].y), pk2(xv[j].z, xv[j].w)}; }
            if (rout) {
                float s2 = 0.f;
#pragma unroll
                for (int j = 0; j < 8; ++j) s2 += (xv[j].x * xv[j].x + xv[j].y * xv[j].y) + (xv[j].z * xv[j].z + xv[j].w * xv[j].w);
                const float rs2 = rsqrtf(wave_sum(s2) * (1.0f / DM) + 1e-6f);
                if (lane == 0) rout[row] = rs2;
            }
        }
    }
}
__device__ __forceinline__ void build_tables(unsigned char* ws, int gtid, int ngt) {
    float* csd = (float*)(ws + WS_CSD); float* csm = (float*)(ws + WS_CSM);
    for (int i = gtid; i < SEQ * 24; i += ngt) {
        const int pos = i / 24, k = i % 24;
        const bool dd = k < 8; const int kk = dd ? k : k - 8;
        const float inv = __builtin_amdgcn_exp2f(-(float)kk * (dd ? 0.125f : 0.0625f) * 18.931568569324174f);
        const float ang = (float)pos * inv;
        float rev = ang * 0.15915494309189535f; rev = rev - __builtin_floorf(rev);
        const float c = __builtin_amdgcn_cosf(rev), sn = __builtin_amdgcn_sinf(rev);
        if (dd) { csd[pos * 16 + kk] = c; csd[pos * 16 + 8 + kk] = sn; } else { csm[pos * 32 + kk] = c; csm[pos * 32 + 16 + kk] = sn; }
    }
}
__device__ __forceinline__ void prep_phase(unsigned char* ws, LAS unsigned char* lds, int tid, int bx, int G) {
    const bf16* QKV = (const bf16*)(ws + WS_R1); bf16* VT = (bf16*)(ws + WS_VT); float* kmean = (float*)(ws + WS_KMEAN);
    for (int it = bx; it < 4096; it += G) {
        const int st = it & 63, hh = (it >> 6) & 7, b = (it >> 9) & 3, vt = it >> 11;
        const int s0 = st * 64, vcol = (vt ? 5120 : 2048) + hh * 128;
#pragma unroll
        for (int i = 0; i < 2; ++i) { const int id = tid + 512 * i, row = id >> 4, c = id & 15;
            const v4u w = *(const v4u*)(QKV + ((size_t)b * SEQ + s0 + row) * QKVW + vcol + c * 8);
            LAS unsigned* d = (LAS unsigned*)(lds + row * 260 + c * 16); d[0] = w.x; d[1] = w.y; d[2] = w.z; d[3] = w.w; }
        __syncthreads();
        { const int d = tid >> 2, sq = tid & 3; unsigned short e[16];
#pragma unroll
          for (int i = 0; i < 16; ++i) e[i] = *(const LAS unsigned short*)(lds + (16 * sq + i) * 260 + d * 2);
          v4u w0, w1;
          w0.x = e[0] | ((unsigned)e[1] << 16); w0.y = e[2] | ((unsigned)e[3] << 16); w0.z = e[4] | ((unsigned)e[5] << 16); w0.w = e[6] | ((unsigned)e[7] << 16);
          w1.x = e[8] | ((unsigned)e[9] << 16); w1.y = e[10] | ((unsigned)e[11] << 16); w1.z = e[12] | ((unsigned)e[13] << 16); w1.w = e[14] | ((unsigned)e[15] << 16);
          bf16* dst = VT + ((size_t)(vt * 32 + b * 8 + hh) * 128 + d) * SEQ + s0 + 16 * sq;
          *(v4u*)dst = w0; *(v4u*)(dst + 8) = w1; }
        __syncthreads();
    }
    for (int it = bx; it < 512; it += G) {
        const int blk = it & 15, hh = (it >> 4) & 7, b = it >> 7;
        const int dg = tid & 15, rg = tid >> 4;
        float a[8];
#pragma unroll
        for (int e = 0; e < 8; ++e) a[e] = 0.f;
#pragma unroll
        for (int i = 0; i < 8; ++i) { const v4u w = *(const v4u*)(QKV + ((size_t)b * SEQ + blk * 256 + rg + 32 * i) * QKVW + 4096 + hh * 128 + dg * 8);
            a[0] += __uint_as_float(w.x << 16); a[1] += __uint_as_float(w.x & 0xffff0000u); a[2] += __uint_as_float(w.y << 16); a[3] += __uint_as_float(w.y & 0xffff0000u);
            a[4] += __uint_as_float(w.z << 16); a[5] += __uint_as_float(w.z & 0xffff0000u); a[6] += __uint_as_float(w.w << 16); a[7] += __uint_as_float(w.w & 0xffff0000u); }
        LAS float* part = (LAS float*)lds;
#pragma unroll
        for (int e = 0; e < 8; ++e) part[rg * 128 + dg * 8 + e] = a[e];
        __syncthreads();
        if (tid < 128) { float s = 0.f;
#pragma unroll
            for (int r = 0; r < 32; ++r) s += part[r * 128 + tid];
            kmean[(size_t)((b * 8 + hh) * 16 + blk) * 128 + tid] = s * (1.0f / 256.0f); }
        __syncthreads();
    }
}
#define XB_TMO      128
#define XB_XCNT(j)  (256  + 64 * (j))
#define XB_XSUB(j)  (1280 + 64 * (j))
#define XB_XGEN(j)  (2304 + 64 * (j))
#define XB_TOP      3328
#define XB_TOPGEN   3392
#define XCD_BAR_WORDS 3456
#define XB_SPIN_CAP (1u << 18)

__device__ __forceinline__ unsigned xb_ld(unsigned* p)              { return __hip_atomic_load(p, __ATOMIC_RELAXED, __HIP_MEMORY_SCOPE_AGENT); }
__device__ __forceinline__ unsigned xb_add(unsigned* p, unsigned v) { return __hip_atomic_fetch_add(p, v, __ATOMIC_RELAXED, __HIP_MEMORY_SCOPE_AGENT); }
__device__ __forceinline__ unsigned xb_xcc_id() { return (unsigned)__builtin_amdgcn_s_getreg((3 << 11) | 20) & 0xFu; }
#define XB_SPIN(cond, bar) do { unsigned _sp = 0; while (cond) { __builtin_amdgcn_s_sleep(1); \
    if ((++_sp & 255u) == 0u) { if (xb_ld(&(bar)[XB_TMO])) break; if (_sp > XB_SPIN_CAP) { atomicAdd(&(bar)[XB_TMO], 1u); break; } } } } while (0)

struct XcdBarrier {
    unsigned* bar; unsigned x;
    volatile LAS unsigned* st;
};

__device__ __forceinline__ XcdBarrier xcd_barrier_post(unsigned* bar, volatile LAS unsigned* st) {
    XcdBarrier b; b.bar = bar; b.x = xb_xcc_id(); b.st = st;
    if (threadIdx.x == 0) (void)xb_add(&bar[XB_XCNT(b.x)], 1u);
    return b;
}
__device__ __forceinline__ void xcd_barrier_complete(unsigned* bar, unsigned x, unsigned& nloc, unsigned& nx) {
    const unsigned G = gridDim.x * gridDim.y * gridDim.z;
    unsigned sum, cnt, mine, sp = 0u;
    for (;;) {
        sum = 0u; cnt = 0u; mine = 0u;
#pragma unroll
        for (unsigned j = 0; j < 16; ++j) { const unsigned c = xb_ld(&bar[XB_XCNT(j)]); sum += c; cnt += (c > 0u) ? 1u : 0u; mine = (j == x) ? c : mine; }
        if (sum == G) break;
        __builtin_amdgcn_s_sleep(1);
        if ((++sp & 255u) == 0u) { if (xb_ld(&bar[XB_TMO])) break; if (sp > XB_SPIN_CAP) { atomicAdd(&bar[XB_TMO], 1u); break; } }
    }
    nloc = mine > 0u ? mine : 1u; nx = cnt > 0u ? cnt : 1u;
}

__device__ __forceinline__ void xcd_barrier(const XcdBarrier& b) {
    asm volatile("s_waitcnt vmcnt(0)" ::: "memory");
    __syncthreads();
    if (threadIdx.x == 0) {
        unsigned* bar = b.bar;
        __builtin_amdgcn_s_waitcnt(0);
        unsigned nloc = b.st[0], nx = b.st[1];
        if (nloc == 0u) { xcd_barrier_complete(bar, b.x, nloc, nx); b.st[0] = nloc; b.st[1] = nx; }
        const unsigned old = xb_add(&bar[XB_XSUB(b.x)], 1u);
        const unsigned gen = old / nloc;
        if (old + 1u == (gen + 1u) * nloc) {
            __builtin_amdgcn_fence(__ATOMIC_RELEASE, "agent");
            asm volatile("s_waitcnt vmcnt(0)" ::: "memory");
            const unsigned og = xb_add(&bar[XB_TOP], 1u);
            const unsigned tg = og / nx;
            if (og + 1u == (tg + 1u) * nx) xb_add(&bar[XB_TOPGEN], 1u);
            else XB_SPIN(xb_ld(&bar[XB_TOPGEN]) == tg, bar);
            __builtin_amdgcn_fence(__ATOMIC_ACQUIRE, "agent");
            xb_add(&bar[XB_XGEN(b.x)], 1u);
            asm volatile("s_waitcnt vmcnt(0)" ::: "memory");
        } else {
            XB_SPIN(xb_ld(&bar[XB_XGEN(b.x)]) == gen, bar);
            __builtin_amdgcn_fence(__ATOMIC_ACQUIRE, "agent");
            asm volatile("s_waitcnt vmcnt(0)" ::: "memory");
        }
    }
    __syncthreads();
}

__global__ void __launch_bounds__(NTHR, 2) fwd_kernel(Params P) {
    extern __shared__ __attribute__((aligned(16))) unsigned char lds_raw[];
    LAS unsigned char* lds = (LAS unsigned char*)lds_raw;
    cg::grid_group grid = cg::this_grid();
    if (threadIdx.x < 2) ((LAS unsigned*)(lds + LDS_BARST))[threadIdx.x] = 0u;
    __syncthreads();
    int ph_lo, ph_hi;
    { KP k0 = (KP)__builtin_amdgcn_kernarg_segment_ptr(); ph_lo = k0->ph_lo; ph_hi = k0->ph_hi; }
#pragma unroll 1
    for (int ph = ph_lo; ph < ph_hi; ++ph) {
        KP Pp = (KP)__builtin_amdgcn_kernarg_segment_ptr(); asm volatile("" : "+s"(Pp));
        int tid_ = threadIdx.x; asm volatile("" : "+v"(tid_));
        int G = gridDim.x, bx = blockIdx.x; asm volatile("" : "+s"(G), "+s"(bx));
        unsigned char* ws = Pp->ws;
        bf16* H = (bf16*)(ws + WS_H); bf16* YZ = (bf16*)(ws + WS_YZ); bf16* ACT = (bf16*)(ws + WS_R1); bf16* QKV = (bf16*)(ws + WS_R1); bf16* GATE = (bf16*)(ws + WS_GATE);
        bf16* VT = (bf16*)(ws + WS_VT); bf16* MRG = (bf16*)(ws + WS_MRG); bf16* YA = (bf16*)(ws + WS_YA); bf16* YB = (bf16*)(ws + WS_YB);

        const int tid = tid_, lane = tid & 63, wave = __builtin_amdgcn_readfirstlane(tid >> 6);
        const int gw = bx * NWAVES + wave, ngw = G * NWAVES;
        if (ph >= 1 && (ph - 1) % 12 == 4) continue;
        if (ph == 0) {
            if (bx == 0) for (int w = tid; w < XCD_BAR_WORDS; w += NTHR) ((unsigned*)(ws + WS_BAR))[w] = 0u;
            build_tables(ws, bx * NTHR + tid, G * NTHR);
            convert_weights(Pp, 0, lds, gw, ngw, wave, lane);
            ew_rows<false, true>(Pp->in[I_X], nullptr, (bf16*)Pp->out, nullptr, 0.f, nullptr, (float*)(ws + WS_RSTD), gw, ngw, lane);
        } else {
            const int l = (ph - 1) / 12, k = (ph - 1) % 12;
#ifndef NO_GU
            if (k == 0 || k == 9) {
                pg8::Gemm g{(const bf16*)Pp->out, (const bf16*)(ws + (k == 0 ? WS_WGU1 : WS_WGU2)), TOK, 2 * DFF, DM};
                pg8::StaticOrderT<2 * DFF> S; S.init(TOK, 2 * DFF, G, bx);
                pg8::EpiSwiglu E{ACT, DFF, (const float*)(ws + WS_RSTD)};
                pg8::gemm_phase<pg8::EpiSwiglu, pg8::StaticOrderT<2 * DFF>, true, true>(lds, g, S, E);
            } else
#endif
#ifndef NO_ST
            if (k == 1 || k == 10) {
                pg8::Gemm g{ACT, (const bf16*)(ws + (k == 1 ? WS_WDN1 : WS_WDN2)), TOK, DM, DFF};
                pg8::StaticOrderT<DM> S; S.init(TOK, DM, G, bx);
                pg8::EpiStore E{YZ, DM};
                pg8::gemm_phase<pg8::EpiStore, pg8::StaticOrderT<DM>, true, true>(lds, g, S, E);
            } else if (k == 7) {
                pg8::Gemm g{MRG, (const bf16*)(ws + WS_WO), TOK, DM, DM};
                pg8::StaticOrderT<DM> S; S.init(TOK, DM, G, bx);
                pg8::EpiStore E{YZ, DM};
                pg8::gemm_phase<pg8::EpiStore, pg8::StaticOrderT<DM>, true, true>(lds, g, S, E);
            } else
#endif
#ifndef NO_EW
            if (k == 2 || k == 8 || k == 11) {
                const float* gpost = Pp->in[k == 2 ? I_F1POST : k == 8 ? I_MIXPOST : I_F2POST] + l * DM;
                const float* gpre = k == 2 ? Pp->in[I_MIXPRE] + l * DM : k == 8 ? Pp->in[I_F2PRE] + l * DM : Pp->in[I_F1PRE] + (l + 1) * DM;
                const bool last = (k == 11 && l + 1 == NL);
                if (k == 2 && bx == 0) for (int w = tid; w < NB * 8 * 16 * 128; w += NTHR) ((float*)(ws + WS_KMEAN))[w] = 0.f;
                const float sc = k == 8 ? 1.0f : 0.5f;
                bf16* XB = (bf16*)Pp->out; float* XF = (float*)(ws + WS_GATE);
                float* RS = (float*)(ws + WS_RSTD);
                if (k == 2 && l == 0) ew_rows<false, true>(Pp->in[I_X], XB, nullptr, YZ, sc, gpost, RS, gw, ngw, lane);
                else if (last) ew_rows<false, false>(XF, Pp->out, nullptr, YZ, sc, gpost, nullptr, gw, ngw, lane);
                else if (k == 8 && l + 1 == NL) ew_rows<true, false>(XB, XF, XB, YZ, sc, gpost, RS, gw, ngw, lane);
                else ew_rows<true, true>(XB, XB, nullptr, YZ, sc, gpost, RS, gw, ngw, lane);
                if (k == 11 && !last) convert_weights(Pp, l + 1, lds, gw, ngw, wave, lane);
            } else
#endif
#ifndef NO_PROJ
            if (k == 3) {
                pg8::Gemm g{(const bf16*)Pp->out, (const bf16*)(ws + WS_WIN), TOK, INW, DM};
                pg8::StaticOrderT<INW> S; S.init(TOK, INW, G, bx);
                pg8::EpiProj E{QKV, GATE, (const float*)(ws + WS_CSD), (const float*)(ws + WS_CSM), (const float*)(ws + WS_RSTD), VT, (float*)(ws + WS_KMEAN)};
                pg8::gemm_phase<pg8::EpiProj, pg8::StaticOrderT<INW>, true, true>(lds, g, S, E);
            } else
#endif
#ifndef NO_PREP
            if (k == 4) {
                prep_phase(ws, lds, tid, bx, G);
            } else
#endif
#ifndef NO_ATT
            if (k == 5) {
                const float linit = l == 0 ? 0.2f : 0.35550906759f;
                const float d1 = wave_sum(Pp->in[I_LQ1][l * 64 + lane] * Pp->in[I_LK1][l * 64 + lane]);
                const float d2 = wave_sum(Pp->in[I_LQ2][l * 64 + lane] * Pp->in[I_LK2][l * 64 + lane]);
                const float lam = __builtin_amdgcn_exp2f(d1 * LOG2E) - __builtin_amdgcn_exp2f(d2 * LOG2E) + linit;
                const int vcu = (G % 8 == 0) ? (bx % 8) * (G / 8) + bx / 8 : bx;
#ifndef REP_ATT
#define REP_ATT 1
#endif
                for (int rep = 0; rep < REP_ATT; ++rep)
                for (int u = vcu; u < 256; u += G) {
                    const int bh = u >> 3, s = u & 7, b = bh >> 3, hh = bh & 7;
                    att::attn_unit<1>(lds, QKV, VT, (const float*)(ws + WS_KMEAN), YB, b, hh, s, 0.f, 0.f, nullptr);
                    att::attn_unit<1>(lds, QKV, VT, (const float*)(ws + WS_KMEAN), YB, b, hh, 15 - s, 0.f, 0.f, nullptr);
#pragma unroll 1
                    for (int i = 0; i < 4; ++i) {
                        const int qb = i == 0 ? s : i == 1 ? 15 - s : i == 2 ? 16 + s : 31 - s;
                        att::attn_unit<0>(lds, QKV, VT, nullptr, YA, b, hh, qb, lam, 1.0f - linit, Pp->in[I_SUBG] + l * 128);
                    }
                }
            } else
#endif
#ifndef NO_BR
            if (k == 6) {
                static_assert(WS_YB == WS_YA + (size_t)TOK * 1024 * 2 && WS_WBM == WS_WBD + (size_t)DM * 1024 * 2, "stacked branch operands must be adjacent");
                pg8::BranchOrder S; S.init(G, bx);
                pg8::Gemm g{YA, (const bf16*)(ws + WS_WBD), 2 * TOK, 2 * DM, 1024}; pg8::EpiGate2 E{MRG, GATE};
                pg8::gemm_phase<pg8::EpiGate2, pg8::BranchOrder, true, true>(lds, g, S, E);
            } else
#endif
            {}
        }
        if (ph + 1 < ph_hi) {
            if (ph == ph_lo) { grid.sync(); (void)xcd_barrier_post((unsigned*)(ws + WS_BAR), (volatile LAS unsigned*)(lds + LDS_BARST)); }
            else { XcdBarrier xb_; xb_.bar = (unsigned*)(ws + WS_BAR); xb_.x = xb_xcc_id(); xb_.st = (volatile LAS unsigned*)(lds + LDS_BARST); xcd_barrier(xb_); }
        }
    }
}

constexpr int N_PHASES = 1 + 12 * NL;
extern "C" void kernel_launch(void* const* d_in, const int* in_sizes, int n_in, void* d_out, int out_size, void* d_ws, size_t ws_size, hipStream_t stream) {
    static int grid = 0;
    if (grid == 0) {
        if (n_in != 20 || in_sizes[0] != TOK * DM || out_size != TOK * DM || ws_size < WS_END) { fprintf(stderr, "kernel_launch: unexpected shapes (n_in %d, in0 %d, out %d, ws %zu; need ws >= %zu)\n", n_in, n_in > 0 ? in_sizes[0] : -1, out_size, ws_size, (size_t)WS_END); grid = -1; return; }
        int dev = 0, cus = 0, per_cu = 0;
        (void)hipGetDevice(&dev); (void)hipDeviceGetAttribute(&cus, hipDeviceAttributeMultiprocessorCount, dev);
        if (hipFuncSetAttribute((const void*)fwd_kernel, hipFuncAttributeMaxDynamicSharedMemorySize, LDS_BYTES) != hipSuccess) { fprintf(stderr, "kernel_launch: hipFuncSetAttribute failed\n"); }
        if (hipOccupancyMaxActiveBlocksPerMultiprocessor(&per_cu, (const void*)fwd_kernel, NTHR, LDS_BYTES) != hipSuccess || per_cu < 1) { fprintf(stderr, "kernel_launch: occupancy query gave %d\n", per_cu); per_cu = 1; }
        (void)hipGetLastError();
        if (per_cu > 1) per_cu = 1;
        grid = cus * per_cu;
    }
    if (grid < 0) return;
    Params p{};
    for (int i = 0; i < 20; ++i) p.in[i] = (const float*)d_in[i];
    p.out = (float*)d_out; p.ws = (unsigned char*)d_ws; p.ph_lo = 0; p.ph_hi = N_PHASES;
    void* args[] = {&p};
    const hipError_t e = hipLaunchCooperativeKernel((const void*)fwd_kernel, dim3(grid), dim3(NTHR), args, LDS_BYTES, stream);
    if (e != hipSuccess) fprintf(stderr, "kernel_launch: cooperative launch failed: %s (grid %d)\n", hipGetErrorString(e), grid);
}
```

```cpp
#include <hip/hip_runtime.h>
#include <hip/hip_cooperative_groups.h>
#include <cstdio>
#include <cstdint>
namespace cg = cooperative_groups;

constexpr int DM = 2048, NB = 4, SEQ = 4096, NL = 2, TOK = NB * SEQ;
constexpr int DFF = 5632, INW = 10240, QKVW = 6144, GW = 4096;
constexpr float LOG2E = 1.4426950408889634f;
namespace pg8 {
#define PG8_LAS __attribute__((address_space(3)))
typedef unsigned short bf16_t;
typedef short bf16x8 __attribute__((ext_vector_type(8)));
typedef float f32x4 __attribute__((ext_vector_type(4)));
typedef unsigned u32x4 __attribute__((ext_vector_type(4)));
constexpr int BM = 256, BK = 64, HALF = 128, HTB = HALF * BK * 2  , STAGE_BYTES = 8 * HTB, NXCD = 8, WGM = 8;

__host__ __device__ __forceinline__ int lds_byte(int r, int c) { const int st = (r >> 4) * 2 + (c >> 5), rr = r & 15, cc = c & 31, ob = rr * 64 + cc * 2; return st * 1024 + (ob ^ (((ob >> 9) & 1) << 5)); }
__host__ __device__ __forceinline__ void stage_rc(int b, int& R, int& C) { const int st = b / 1024, sb = b % 1024, swz = sb ^ (((sb >> 9) & 1) << 5); R = (st >> 1) * 16 + swz / 64; C = (st & 1) * 32 + (swz % 64) / 2; }
__host__ __device__ __forceinline__ int perm32(int rho) { const int n = rho >> 4, i = rho & 15; return 8 * (i >> 2) + 4 * n + (i & 3); }

struct Unit { int pm, pn; };
struct Gemm { const bf16_t* A; const bf16_t* Bt; int M, N, K; };

struct StaticOrder {
    int nM, nN, nwg, G, c;
    __host__ __device__ void init(int M, int N, int G_, int c_) { nM = M / BM; nN = N / BM; nwg = nM * nN; G = G_; c = c_; }
    __host__ __device__ bool next(int i, Unit& u) const {
        const long L = (long)i * G + c; if (L >= nwg) return false;
        int wgid = (int)L; { const int q = nwg / NXCD, r = nwg % NXCD, xcd = wgid % NXCD, off = wgid / NXCD; wgid = (xcd < r ? xcd * (q + 1) : r * (q + 1) + (xcd - r) * q) + off; }
        const int nig = WGM * nN, gid = wgid / nig, fm = gid * WGM, gsz = (nM - fm) < WGM ? (nM - fm) : WGM;
        u.pm = fm + ((wgid % nig) % gsz); u.pn = (wgid % nig) / gsz; return true;
    }
    __device__ __forceinline__ void a_ready(const Unit&) const {}
    __device__ __forceinline__ void done(const Unit&) const {}
};

template <int N_> struct StaticOrderT {
    static constexpr int nM = 64, nN = N_ / BM, nwg = nM * nN, q = nwg / NXCD, nig = WGM * nN;
    static_assert(nwg % NXCD == 0, "nwg must be a multiple of 8");
    int G, c;
    __host__ __device__ void init(int, int, int G_, int c_) { G = G_; c = c_; }
    __host__ __device__ bool next(int i, Unit& u) const {
        const int L = i * G + c; if (L >= nwg) return false;
        const int w = (L % NXCD) * q + L / NXCD;
        const int gid = w / nig, rem = w % nig;
        u.pm = gid * WGM + (rem % WGM); u.pn = rem / WGM; return true;
    }
    __device__ __forceinline__ void a_ready(const Unit&) const {}
    __device__ __forceinline__ void done(const Unit&) const {}
};

typedef float f32x2_cv __attribute__((ext_vector_type(2))); typedef __bf16 bf16x2_cv __attribute__((ext_vector_type(2)));
__device__ __forceinline__ unsigned cvt_pk_bf16(float lo, float hi) { const f32x2_cv v = {lo, hi}; const bf16x2_cv b = __builtin_convertvector(v, bf16x2_cv); return __builtin_bit_cast(unsigned, b); }
typedef unsigned u32x2 __attribute__((ext_vector_type(2)));
__device__ __forceinline__ float bf_lo(unsigned w) { return __uint_as_float(w << 16); }
__device__ __forceinline__ float bf_hi(unsigned w) { return __uint_as_float(w & 0xffff0000u); }
__device__ __forceinline__ float fast_sigmoid(float v) { return __builtin_amdgcn_rcpf(1.0f + __builtin_amdgcn_exp2f(-v * 1.4426950408889634f)); }

struct EpiStore {
    static constexpr bool PERM = true, AFTER_DRAIN = false;
    bf16_t* O; int ldc;
    __device__ __forceinline__ void operator()(const f32x4 (&acc)[2][2][4][2], const Unit& u, int wr, int wc, int fr, int fq) const {
        const int row0 = u.pm * BM + wr * 64 + fr, col0 = u.pn * BM + wc * 32 + 8 * fq;
#pragma unroll
        for (int ai = 0; ai < 2; ++ai)
#pragma unroll
            for (int m = 0; m < 4; ++m) { bf16_t* rowp = O + (size_t)(row0 + ai * HALF + m * 16) * ldc + col0;
#pragma unroll
                for (int bj = 0; bj < 2; ++bj) { const f32x4 v0 = acc[ai][bj][m][0], v1 = acc[ai][bj][m][1];
                    u32x4 w; w.x = cvt_pk_bf16(v0[0], v0[1]); w.y = cvt_pk_bf16(v0[2], v0[3]); w.z = cvt_pk_bf16(v1[0], v1[1]); w.w = cvt_pk_bf16(v1[2], v1[3]);
                    *(u32x4*)(rowp + bj * HALF) = w; } }
    }
};
struct EpiSwiglu {
    static constexpr bool PERM = true, AFTER_DRAIN = false;
    bf16_t* O; int ldc;
    __device__ __forceinline__ void operator()(const f32x4 (&acc)[2][2][4][2], const Unit& u, int wr, int wc, int fr, int fq) const {
        const int row0 = u.pm * BM + wr * 64 + fr, col0 = u.pn * HALF + wc * 32 + 8 * fq;
#pragma unroll
        for (int ai = 0; ai < 2; ++ai)
#pragma unroll
            for (int m = 0; m < 4; ++m) { bf16_t* rowp = O + (size_t)(row0 + ai * HALF + m * 16) * ldc + col0;
                float r[8];
#pragma unroll
                for (int n = 0; n < 2; ++n)
#pragma unroll
                    for (int j = 0; j < 4; ++j) { const float g = acc[ai][0][m][n][j], up = acc[ai][1][m][n][j]; r[n * 4 + j] = g * up * fast_sigmoid(g); }
                u32x4 w; w.x = cvt_pk_bf16(r[0], r[1]); w.y = cvt_pk_bf16(r[2], r[3]); w.z = cvt_pk_bf16(r[4], r[5]); w.w = cvt_pk_bf16(r[6], r[7]);
                *(u32x4*)rowp = w; }
    }
};
struct EpiProj {
    static constexpr bool PERM = true, AFTER_DRAIN = false;
    bf16_t* QKV; bf16_t* G; const float* csd; const float* csm;
    bf16_t* VT; float* kmean;
    __device__ __forceinline__ void operator()(const f32x4 (&acc)[2][2][4][2], const Unit& u, int wr, int wc, int fr, int fq) const {
        const int colt = u.pn * BM;
        const int row0 = u.pm * BM + wr * 64 + fr;
        const int region = colt < 2048 ? 0 : colt < 3072 ? 1 : colt < 5120 ? 2 : colt < 6144 ? 1 : 3;
        const float qs = colt < 1024 ? 0.125f * LOG2E : (colt >= 3072 && colt < 4096) ? 0.08838834764831845f * LOG2E : 1.0f;
        const bool kmt = colt >= 4096 && colt < 5120;
        float ksum[2][8];
#pragma unroll
        for (int bj = 0; bj < 2; ++bj)
#pragma unroll
            for (int e = 0; e < 8; ++e) ksum[bj][e] = 0.f;
#pragma unroll
        for (int ai = 0; ai < 2; ++ai)
#pragma unroll
            for (int m = 0; m < 4; ++m) {
                const int row = row0 + ai * HALF + m * 16; const int pos = row & (SEQ - 1);
#pragma unroll
                for (int bj = 0; bj < 2; ++bj) {
                    float v[8];
#pragma unroll
                    for (int n = 0; n < 2; ++n)
#pragma unroll
                        for (int j = 0; j < 4; ++j) v[n * 4 + j] = acc[ai][bj][m][n][j];
                    if (region == 0) {
                        if ((wc & 1) == 0) {
                            float pr[8];
#pragma unroll
                            for (int e = 0; e < 8; ++e) pr[e] = __shfl_xor(v[e], 16);
                            if (fq < 2) {
                                const f32x4* cp = (const f32x4*)(csd + pos * 16);
                                const f32x4 c0 = cp[0], c1 = cp[1], s0 = cp[2], s1 = cp[3];
                                const float cs[8] = {c0[0], c0[1], c0[2], c0[3], c1[0], c1[1], c1[2], c1[3]};
                                const float sn[8] = {s0[0], s0[1], s0[2], s0[3], s1[0], s1[1], s1[2], s1[3]};
                                const float sg = fq == 0 ? -1.f : 1.f;
#pragma unroll
                                for (int e = 0; e < 8; ++e) v[e] = v[e] * cs[e] + sg * pr[e] * sn[e];
                            }
                        }
#pragma unroll
                        for (int e = 0; e < 8; ++e) v[e] *= qs;
                    } else if (region == 2) {
                        if (wc == 0) {
                            float pr[8];
#pragma unroll
                            for (int e = 0; e < 8; ++e) pr[e] = __shfl_xor(v[e], 32);
                            const f32x4* cp = (const f32x4*)(csm + pos * 32 + (fq & 1) * 8);
                            const f32x4 c0 = cp[0], c1 = cp[1], s0 = cp[4], s1 = cp[5];
                            const float cs[8] = {c0[0], c0[1], c0[2], c0[3], c1[0], c1[1], c1[2], c1[3]};
                            const float sn[8] = {s0[0], s0[1], s0[2], s0[3], s1[0], s1[1], s1[2], s1[3]};
                            const float sg = fq < 2 ? -1.f : 1.f;
#pragma unroll
                            for (int e = 0; e < 8; ++e) v[e] = v[e] * cs[e] + sg * pr[e] * sn[e];
                        }
#pragma unroll
                        for (int e = 0; e < 8; ++e) v[e] *= qs;
                        if (kmt) {
#pragma unroll
                            for (int e = 0; e < 8; ++e) ksum[bj][e] += v[e];
                        }
                    } else if (region == 3) {
#pragma unroll
                        for (int e = 0; e < 8; ++e) v[e] = fast_sigmoid(v[e]);
                    }
                    if (region == 1) {
                        const int vt = colt >= 5120 ? 1 : 0, head = ((colt - (vt ? 5120 : 2048)) >> 7) + bj;
                        const bool odd = fr & 1;
                        bf16_t* vb = VT + ((size_t)((vt * 32 + (row >> 12) * 8 + head) * 128 + wc * 32 + 8 * fq + (odd ? 4 : 0)) * SEQ + (pos & ~1));
#pragma unroll
                        for (int i = 0; i < 4; ++i) {
                            const float snd = odd ? v[i] : v[4 + i];
                            const float rcv = __shfl_xor(snd, 1);
                            const unsigned w2 = odd ? cvt_pk_bf16(rcv, v[4 + i]) : cvt_pk_bf16(v[i], rcv);
                            *(unsigned*)(vb + (size_t)i * SEQ) = w2;
                        }
                    } else {
                    u32x4 w; w.x = cvt_pk_bf16(v[0], v[1]); w.y = cvt_pk_bf16(v[2], v[3]); w.z = cvt_pk_bf16(v[4], v[5]); w.w = cvt_pk_bf16(v[6], v[7]);
                    const int col = colt + bj * HALF + wc * 32 + 8 * fq;
                    bf16_t* dst = (region == 3) ? (G + (size_t)row * GW + (col - QKVW)) : (QKV + (size_t)row * QKVW + col);
                    *(u32x4*)dst = w;
                    }
                }
            }
        if (kmt) {
#pragma unroll
            for (int bj = 0; bj < 2; ++bj)
#pragma unroll
                for (int e = 0; e < 8; ++e) { float t = ksum[bj][e]; t += __shfl_xor(t, 1); t += __shfl_xor(t, 2); t += __shfl_xor(t, 4); t += __shfl_xor(t, 8); ksum[bj][e] = t; }
            if (fr == 0) {
                const int bb = u.pm >> 4, blk = u.pm & 15;
#pragma unroll
                for (int bj = 0; bj < 2; ++bj) { const int head = ((colt - 4096) >> 7) + bj;
                    float* kp = kmean + (size_t)((bb * 8 + head) * 16 + blk) * 128 + wc * 32 + 8 * fq;
#pragma unroll
                    for (int e = 0; e < 8; ++e) atomicAdd(kp + e, ksum[bj][e] * (1.0f / 256.0f)); }
            }
        }
    }
};
template <bool ADD> struct EpiGate {
    static constexpr bool PERM = true, AFTER_DRAIN = false;
    bf16_t* O; const bf16_t* G; int gcol0;
    __device__ __forceinline__ void operator()(const f32x4 (&acc)[2][2][4][2], const Unit& u, int wr, int wc, int fr, int fq) const {
        const int row0 = u.pm * BM + wr * 64 + fr, col0 = u.pn * BM + wc * 32 + 8 * fq;
#pragma unroll
        for (int ai = 0; ai < 2; ++ai)
#pragma unroll
            for (int m = 0; m < 4; ++m) { const int row = row0 + ai * HALF + m * 16;
#pragma unroll
                for (int bj = 0; bj < 2; ++bj) { const int col = col0 + bj * HALF;
                    const u32x4 g = *(const u32x4*)(G + (size_t)row * GW + gcol0 + col);
                    float r[8];
                    r[0] = acc[ai][bj][m][0][0] * bf_lo(g.x); r[1] = acc[ai][bj][m][0][1] * bf_hi(g.x); r[2] = acc[ai][bj][m][0][2] * bf_lo(g.y); r[3] = acc[ai][bj][m][0][3] * bf_hi(g.y);
                    r[4] = acc[ai][bj][m][1][0] * bf_lo(g.z); r[5] = acc[ai][bj][m][1][1] * bf_hi(g.z); r[6] = acc[ai][bj][m][1][2] * bf_lo(g.w); r[7] = acc[ai][bj][m][1][3] * bf_hi(g.w);
                    bf16_t* dst = O + (size_t)row * DM + col;
                    if (ADD) { const u32x4 o = *(const u32x4*)dst;
                        r[0] += bf_lo(o.x); r[1] += bf_hi(o.x); r[2] += bf_lo(o.y); r[3] += bf_hi(o.y); r[4] += bf_lo(o.z); r[5] += bf_hi(o.z); r[6] += bf_lo(o.w); r[7] += bf_hi(o.w); }
                    u32x4 w; w.x = cvt_pk_bf16(r[0], r[1]); w.y = cvt_pk_bf16(r[2], r[3]); w.z = cvt_pk_bf16(r[4], r[5]); w.w = cvt_pk_bf16(r[6], r[7]);
                    *(u32x4*)dst = w; } }
    }
};

struct BranchOrder {
    StaticOrderT<2048> base;
    __host__ __device__ void init(int G_, int c_) { base.init(0, 0, G_, c_); }
    __host__ __device__ bool next(int i, Unit& u) const { if (!base.next(i >> 1, u)) return false; if (i & 1) { u.pm += 64; u.pn += 8; } return true; }
    __device__ __forceinline__ void a_ready(const Unit&) const {}
    __device__ __forceinline__ void done(const Unit&) const {}
};
struct EpiGate2 {
    static constexpr bool PERM = true, AFTER_DRAIN = false;
    bf16_t* O; const bf16_t* G;
    __device__ __forceinline__ void operator()(const f32x4 (&acc)[2][2][4][2], const Unit& u, int wr, int wc, int fr, int fq) const {
        const bool add = u.pm >= 64;
        const int row0 = (u.pm & 63) * BM + wr * 64 + fr, col0 = (u.pn & 7) * BM + wc * 32 + 8 * fq, gcol0 = add ? 2048 : 0;
#pragma unroll
        for (int ai = 0; ai < 2; ++ai)
#pragma unroll
            for (int m = 0; m < 4; ++m) { const int row = row0 + ai * HALF + m * 16;
#pragma unroll
                for (int bj = 0; bj < 2; ++bj) { const int col = col0 + bj * HALF;
                    const u32x4 g = *(const u32x4*)(G + (size_t)row * GW + gcol0 + col);
                    float r[8];
                    r[0] = acc[ai][bj][m][0][0] * bf_lo(g.x); r[1] = acc[ai][bj][m][0][1] * bf_hi(g.x); r[2] = acc[ai][bj][m][0][2] * bf_lo(g.y); r[3] = acc[ai][bj][m][0][3] * bf_hi(g.y);
                    r[4] = acc[ai][bj][m][1][0] * bf_lo(g.z); r[5] = acc[ai][bj][m][1][1] * bf_hi(g.z); r[6] = acc[ai][bj][m][1][2] * bf_lo(g.w); r[7] = acc[ai][bj][m][1][3] * bf_hi(g.w);
                    bf16_t* dst = O + (size_t)row * DM + col;
                    if (add) { const u32x4 o = *(const u32x4*)dst;
                        r[0] += bf_lo(o.x); r[1] += bf_hi(o.x); r[2] += bf_lo(o.y); r[3] += bf_hi(o.y); r[4] += bf_lo(o.z); r[5] += bf_hi(o.z); r[6] += bf_lo(o.w); r[7] += bf_hi(o.w); }
                    u32x4 w; w.x = cvt_pk_bf16(r[0], r[1]); w.y = cvt_pk_bf16(r[2], r[3]); w.z = cvt_pk_bf16(r[4], r[5]); w.w = cvt_pk_bf16(r[6], r[7]);
                    *(u32x4*)dst = w; } }
    }
};

template <class Epi, class Sched, bool ALIGN_EPI = false, bool SP2 = false>
__device__ __forceinline__ void gemm_phase(PG8_LAS unsigned char* lds, const Gemm g, const Sched& S, const Epi& E) {
    int tid_ = threadIdx.x; asm volatile("" : "+v"(tid_));
    const int tid = tid_, wid = __builtin_amdgcn_readfirstlane(tid >> 6), lane = tid & 63, wr = wid >> 2, wc = wid & 3, fr = lane & 15, fq = lane >> 4;
    const int K = g.K, nt = K / BK;
    unsigned voffA[2], voffB[2];
#pragma unroll
    for (int i = 0; i < 2; ++i) { int R, C; stage_rc(tid * 16 + i * 8192, R, C); const int Rb = Epi::PERM ? ((R & ~31) + perm32(R & 31)) : R;
        voffA[i] = (unsigned)(R * K + C) * 2u; voffB[i] = (unsigned)(Rb * K + C) * 2u; }
    const size_t kstep = (size_t)(BK * 2);
    const size_t hstep = (size_t)HALF * K * 2;
    const size_t tstep = 2 * hstep;
    const unsigned ldsw = (unsigned)wid * 1024u;
    const int aoff = lds_byte(wr * 64 + fr, fq * 8), boff = lds_byte(wc * 32 + fr, fq * 8);
#define PG8_SA(b, h) (((b) * 2 + (h)) * HTB)
#define PG8_SB(b, h) ((4 + (b) * 2 + (h)) * HTB)
#define PG8_STAGE(bufoff, gbase, voff) do { _Pragma("unroll") for (int _i = 0; _i < 2; ++_i) \
        __builtin_amdgcn_global_load_lds((const unsigned*)((const char*)(gbase) + (voff)[_i]), (PG8_LAS unsigned*)(lds + (bufoff) + ldsw + _i * 8192), 16, 0, 0); } while (0)
#define PG8_LDA(dst, b, h) do { _Pragma("unroll") for (int m = 0; m < 4; ++m) _Pragma("unroll") for (int k = 0; k < 2; ++k) dst[m][k] = *(const PG8_LAS bf16x8*)(lds + PG8_SA(b, h) + aoff + m * 2048 + k * 1024); } while (0)
#define PG8_LDB(dst, b, h) do { _Pragma("unroll") for (int n = 0; n < 2; ++n) _Pragma("unroll") for (int k = 0; k < 2; ++k) dst[n][k] = *(const PG8_LAS bf16x8*)(lds + PG8_SB(b, h) + boff + n * 2048 + k * 1024); } while (0)
#define PG8_MMA(ai, bj, At, Bt) do { __builtin_amdgcn_s_setprio(1); _Pragma("unroll") for (int m = 0; m < 4; ++m) _Pragma("unroll") for (int n = 0; n < 2; ++n) _Pragma("unroll") for (int k = 0; k < 2; ++k) \
        acc[ai][bj][m][n] = __builtin_amdgcn_mfma_f32_16x16x32_bf16(Bt[n][k], At[m][k], acc[ai][bj][m][n], 0, 0, 0); __builtin_amdgcn_s_setprio(0); } while (0)
#define PG8_WAIT_V(n) asm volatile("s_waitcnt vmcnt(" #n ")" ::: "memory")
#define PG8_WAIT_L(n) asm volatile("s_waitcnt lgkmcnt(" #n ")" ::: "memory")
#define PG8_BAR __builtin_amdgcn_s_barrier()
#define PG8_SCHED __builtin_amdgcn_sched_barrier(0)
    Unit cur, nxt; int ui = 0;
    if (!S.next(0, cur)) return;
    f32x4 acc[2][2][4][2];
#pragma unroll
    for (int a = 0; a < 2; ++a)
#pragma unroll
        for (int b = 0; b < 2; ++b)
#pragma unroll
            for (int m = 0; m < 4; ++m)
#pragma unroll
                for (int n = 0; n < 2; ++n) acc[a][b][m][n] = (f32x4){0.f, 0.f, 0.f, 0.f};
    bf16x8 At[4][2], B0[2][2], B1[2][2];
    const char* cA = (const char*)g.A + (size_t)cur.pm * tstep; const char* cB = (const char*)g.Bt + (size_t)cur.pn * tstep;
    S.a_ready(cur);
    if constexpr (SP2) {
        PG8_STAGE(PG8_SB(0, 0), cB, voffB); PG8_STAGE(PG8_SB(0, 1), cB + hstep, voffB); PG8_STAGE(PG8_SA(0, 0), cA, voffA); PG8_STAGE(PG8_SA(0, 1), cA + hstep, voffA);
        if (wr == 1) PG8_BAR;
        PG8_WAIT_V(2); PG8_BAR;
        PG8_STAGE(PG8_SB(1, 0), cB + kstep, voffB); PG8_STAGE(PG8_SA(1, 0), cA + kstep, voffA); PG8_STAGE(PG8_SB(1, 1), cB + hstep + kstep, voffB);
        PG8_WAIT_V(6); PG8_BAR;
    } else {
        PG8_STAGE(PG8_SB(0, 0), cB, voffB); PG8_STAGE(PG8_SA(0, 0), cA, voffA); PG8_STAGE(PG8_SB(0, 1), cB + hstep, voffB); PG8_STAGE(PG8_SA(0, 1), cA + hstep, voffA);
        if (wr == 1) PG8_BAR;
        PG8_WAIT_V(4); PG8_BAR;
        PG8_STAGE(PG8_SB(1, 0), cB + kstep, voffB); PG8_STAGE(PG8_SA(1, 0), cA + kstep, voffA); PG8_STAGE(PG8_SB(1, 1), cB + hstep + kstep, voffB);
        PG8_WAIT_V(6); PG8_BAR;
    }
    for (;;) {
        const bool has_next = S.next(ui + 1, nxt);
        const char* nA = has_next ? (const char*)g.A + (size_t)nxt.pm * tstep : cA; const char* nB = has_next ? (const char*)g.Bt + (size_t)nxt.pn * tstep : cB;
        for (int t = 0; t < nt; t += 2) {
            const bool last = (t == nt - 2);
            const char* a1 = cA + (size_t)(t + 1) * kstep;
            const char* a2 = last ? nA : cA + (size_t)(t + 2) * kstep; const char* b2 = last ? nB : cB + (size_t)(t + 2) * kstep;
            const char* a3 = a2 + kstep; const char* b3 = b2 + kstep;
            if (last && has_next) S.a_ready(nxt);
            if constexpr (SP2) {
            PG8_LDB(B0, 0, 0); PG8_LDB(B1, 0, 1); PG8_SCHED; PG8_LDA(At, 0, 0); PG8_STAGE(PG8_SA(1, 1), a1 + hstep, voffA);
            PG8_WAIT_V(8); PG8_WAIT_L(0); PG8_BAR; PG8_MMA(0, 0, At, B0); PG8_MMA(0, 1, At, B1); PG8_BAR; PG8_SCHED;
            PG8_LDA(At, 0, 1); PG8_STAGE(PG8_SB(0, 0), b2, voffB); PG8_STAGE(PG8_SB(0, 1), b2 + hstep, voffB); PG8_STAGE(PG8_SA(0, 0), a2, voffA);
            PG8_WAIT_V(8); PG8_WAIT_L(0); PG8_BAR; PG8_MMA(1, 0, At, B0); PG8_MMA(1, 1, At, B1); PG8_BAR; PG8_SCHED;
            PG8_LDB(B0, 1, 0); PG8_LDB(B1, 1, 1); PG8_SCHED; PG8_LDA(At, 1, 0); PG8_STAGE(PG8_SA(0, 1), a2 + hstep, voffA);
            PG8_WAIT_V(8); PG8_WAIT_L(0); PG8_BAR; PG8_MMA(0, 0, At, B0); PG8_MMA(0, 1, At, B1); PG8_BAR; PG8_SCHED;
            PG8_LDA(At, 1, 1); PG8_STAGE(PG8_SB(1, 0), b3, voffB); PG8_STAGE(PG8_SB(1, 1), b3 + hstep, voffB); PG8_STAGE(PG8_SA(1, 0), a3, voffA);
            PG8_WAIT_V(8); PG8_WAIT_L(0); PG8_BAR; PG8_MMA(1, 0, At, B0); PG8_MMA(1, 1, At, B1); PG8_BAR; PG8_SCHED;
            } else {
            PG8_LDB(B0, 0, 0); PG8_SCHED; PG8_LDA(At, 0, 0); PG8_STAGE(PG8_SA(1, 1), a1 + hstep, voffA);
            PG8_WAIT_L(8); PG8_BAR; PG8_WAIT_L(0); PG8_MMA(0, 0, At, B0); PG8_BAR; PG8_SCHED;
            PG8_LDB(B1, 0, 1); PG8_STAGE(PG8_SB(0, 0), b2, voffB);
            PG8_BAR; PG8_WAIT_L(0); PG8_MMA(0, 1, At, B1); PG8_BAR;
            PG8_LDA(At, 0, 1); PG8_STAGE(PG8_SA(0, 0), a2, voffA);
            PG8_BAR; PG8_WAIT_L(0); PG8_MMA(1, 0, At, B0); PG8_BAR; PG8_SCHED;
            PG8_STAGE(PG8_SB(0, 1), b2 + hstep, voffB);
            PG8_WAIT_V(6); PG8_BAR; PG8_MMA(1, 1, At, B1); PG8_BAR;
            PG8_LDB(B0, 1, 0); PG8_SCHED; PG8_LDA(At, 1, 0); PG8_STAGE(PG8_SA(0, 1), a2 + hstep, voffA);
            PG8_WAIT_L(8); PG8_BAR; PG8_WAIT_L(0); PG8_MMA(0, 0, At, B0); PG8_BAR; PG8_SCHED;
            PG8_LDB(B1, 1, 1); PG8_STAGE(PG8_SB(1, 0), b3, voffB);
            PG8_BAR; PG8_WAIT_L(0); PG8_MMA(0, 1, At, B1); PG8_BAR;
            PG8_LDA(At, 1, 1); PG8_STAGE(PG8_SA(1, 0), a3, voffA);
            PG8_BAR; PG8_WAIT_L(0); PG8_MMA(1, 0, At, B0); PG8_BAR; PG8_SCHED;
            PG8_STAGE(PG8_SB(1, 1), b3 + hstep, voffB);
            PG8_WAIT_V(6); PG8_BAR; PG8_MMA(1, 1, At, B1); PG8_BAR;
            }
        }
        if constexpr (ALIGN_EPI) { if (wr == 0) PG8_BAR; }
        if constexpr (!Epi::AFTER_DRAIN) { E(acc, cur, wr, wc, fr, fq); S.done(cur); }
        if (!has_next) break;
#pragma unroll
        for (int a = 0; a < 2; ++a)
#pragma unroll
            for (int b = 0; b < 2; ++b)
#pragma unroll
                for (int m = 0; m < 4; ++m)
#pragma unroll
                    for (int n = 0; n < 2; ++n) acc[a][b][m][n] = (f32x4){0.f, 0.f, 0.f, 0.f};
        cur = nxt; cA = nA; cB = nB; ++ui;
        if constexpr (ALIGN_EPI) { if (wr == 1) PG8_BAR; }
    }
    PG8_WAIT_V(0);
    if constexpr (!ALIGN_EPI) { if (wr == 0) PG8_BAR; }
    PG8_BAR;
    if constexpr (Epi::AFTER_DRAIN) { E.fused(acc, cur, wr, wc, fr, fq, lds, wid, lane); S.done(cur); }
#undef PG8_SA
#undef PG8_SB
#undef PG8_STAGE
#undef PG8_LDA
#undef PG8_LDB
#undef PG8_MMA
#undef PG8_WAIT_V
#undef PG8_WAIT_L
#undef PG8_BAR
#undef PG8_SCHED
}
}
namespace att {
#define LAS __attribute__((address_space(3)))
typedef unsigned short bf16_t;
typedef short bf16x8 __attribute__((ext_vector_type(8)));
typedef short s16x4 __attribute__((ext_vector_type(4)));
typedef float f32x16 __attribute__((ext_vector_type(16)));
typedef float f32x4 __attribute__((ext_vector_type(4)));
typedef unsigned u32x4 __attribute__((ext_vector_type(4)));
typedef unsigned u32x2 __attribute__((ext_vector_type(2)));
typedef float f32x2 __attribute__((ext_vector_type(2)));
constexpr int KP = 272, VP = 144, KBYTES = 64 * KP, VBYTES = 128 * VP, VRING = 2 * KBYTES, STAGE_ALL = 2 * KBYTES + 3 * VBYTES;
constexpr int OFF_SC = STAGE_ALL;
constexpr int OFF_KM = OFF_SC + 16384;
constexpr int OFF_RM = OFF_KM + 8192;
constexpr int OFF_TL = OFF_RM + 1024;
constexpr float NEG = -1e30f;
constexpr int OSTG_PITCH = 272, OSTG_BYTES = 32 * OSTG_PITCH;
#define OSTG_FLUSH(stg_, ybase_) do { _Pragma("unroll") for (int i_ = 0; i_ < 8; ++i_) { const int row_ = i_ * 4 + (lane >> 4), ch_ = lane & 15; \
        const u32x4 v_ = *(const LAS u32x4*)((stg_) + row_ * OSTG_PITCH + ch_ * 16); *(u32x4*)((ybase_) + (size_t)row_ * 1024 + ch_ * 8) = v_; } } while (0)
__device__ __forceinline__ int crow(int r, int hi) { return (r & 3) + 8 * (r >> 2) + 4 * hi; }
typedef __bf16 bf16x2_cv __attribute__((ext_vector_type(2)));
__device__ __forceinline__ unsigned pk2(float lo, float hi) { const f32x2 v = {lo, hi}; const bf16x2_cv b = __builtin_convertvector(v, bf16x2_cv); return __builtin_bit_cast(unsigned, b); }
__device__ __forceinline__ bf16x8 pack8(const f32x16& p, int b) {
    u32x4 w; w.x = pk2(p[b], p[b + 1]); w.y = pk2(p[b + 2], p[b + 3]); w.z = pk2(p[b + 4], p[b + 5]); w.w = pk2(p[b + 6], p[b + 7]);
    return __builtin_bit_cast(bf16x8, w);
}

template <int MODE>
__device__ __forceinline__ void attn_unit(LAS unsigned char* lds, const bf16_t* __restrict__ QKV, const bf16_t* __restrict__ VT, const float* __restrict__ kmean,
                                          bf16_t* __restrict__ Y, int b, int h, int qb, float lam, float oscale, const float* __restrict__ subg) {
    int tid_ = threadIdx.x; asm volatile("" : "+v"(tid_));
    const int tid = tid_, lane = tid & 63, r32 = lane & 31, hi = lane >> 5;
    const int wid = __builtin_amdgcn_readfirstlane(tid >> 6);
    constexpr int QROWS = MODE ? 256 : 128, NDK = MODE ? 8 : 4;
    const int slab = MODE ? wid : (wid >> 1), cmap = MODE ? 0 : (wid & 1);
    const int q0 = qb * QROWS, qpos = q0 + slab * 32 + r32;
    const size_t tokbase = (size_t)b * SEQ;
    const int qcol = MODE ? (3072 + h * 128) : (h * 128 + cmap * 64);
    const int kcol = MODE ? (4096 + h * 128) : (1024 + h * 128);
    const int koff = MODE ? 0 : cmap * 64;
    const bf16_t* VTb = VT + (size_t)(MODE * 32 + b * 8 + h) * 128 * SEQ;
    LAS int* tl = (LAS int*)(lds + OFF_TL);
    unsigned mymask = 0; int ntiles;
    if (MODE == 1) {
        LAS float* km = (LAS float*)(lds + OFF_KM); LAS float* sc = (LAS float*)(lds + OFF_SC); LAS unsigned* rm = (LAS unsigned*)(lds + OFF_RM);
        ((LAS f32x4*)km)[tid] = ((const f32x4*)(kmean + (size_t)(b * 8 + h) * 16 * 128))[tid];
        if (tid == 0) tl[65] = 0;
        __syncthreads();
        {
            const int q = tid >> 1, part = tid & 1;
            float a[8];
#pragma unroll
            for (int j = 0; j < 8; ++j) a[j] = 0.f;
            const bf16_t* qrow = QKV + (tokbase + q0 + q) * QKVW + qcol;
#pragma unroll 1
            for (int dc = 0; dc < 8; ++dc) {
                const u32x4 w0 = *(const u32x4*)(qrow + dc * 16), w1 = *(const u32x4*)(qrow + dc * 16 + 8);
                const float qv[16] = {__uint_as_float(w0.x << 16), __uint_as_float(w0.x & 0xffff0000u), __uint_as_float(w0.y << 16), __uint_as_float(w0.y & 0xffff0000u),
                                      __uint_as_float(w0.z << 16), __uint_as_float(w0.z & 0xffff0000u), __uint_as_float(w0.w << 16), __uint_as_float(w0.w & 0xffff0000u),
                                      __uint_as_float(w1.x << 16), __uint_as_float(w1.x & 0xffff0000u), __uint_as_float(w1.y << 16), __uint_as_float(w1.y & 0xffff0000u),
                                      __uint_as_float(w1.z << 16), __uint_as_float(w1.z & 0xffff0000u), __uint_as_float(w1.w << 16), __uint_as_float(w1.w & 0xffff0000u)};
#pragma unroll
                for (int j = 0; j < 8; ++j) {
                    const LAS f32x4* kp = (const LAS f32x4*)(km + (part * 8 + j) * 128 + dc * 16);
#pragma unroll
                    for (int d4 = 0; d4 < 4; ++d4) { const f32x4 kk = kp[d4]; a[j] += qv[d4 * 4] * kk[0] + qv[d4 * 4 + 1] * kk[1] + qv[d4 * 4 + 2] * kk[2] + qv[d4 * 4 + 3] * kk[3]; }
                }
            }
#pragma unroll
            for (int j = 0; j < 8; ++j) sc[q * 16 + part * 8 + j] = a[j];
        }
        __syncthreads();
        if (tid < 256) {
            unsigned msk = 0;
            const int nsel = qb < 3 ? qb : 3;
            for (int s = 0; s < nsel; ++s) {
                float best = -3.0e38f; int bi = 0;
                for (int j = 0; j < qb; ++j) { const float v = sc[tid * 16 + j]; if (!((msk >> j) & 1u) && v > best) { best = v; bi = j; } }
                msk |= 1u << bi;
            }
            rm[tid] = msk;
            if (msk) __hip_atomic_fetch_or((LAS unsigned*)&tl[65], msk, __ATOMIC_RELAXED, __HIP_MEMORY_SCOPE_WORKGROUP);
        }
        __syncthreads();
        if (tid == 0) {
            const unsigned um = (unsigned)tl[65]; int n = 0;
            for (int i = 0; i < 4; ++i) tl[n++] = qb * 4 + i;
            for (int j = 0; j < qb; ++j) if ((um >> j) & 1u) for (int i = 0; i < 4; ++i) tl[n++] = j * 4 + i;
            tl[64] = n;
        }
        __syncthreads();
        mymask = rm[slab * 32 + r32];
        ntiles = tl[64];
    } else {
        ntiles = 2 * qb + 2;
    }
    bf16x8 qf[NDK];
    { const bf16_t* qp = QKV + (tokbase + qpos) * QKVW + qcol + hi * 8;
#pragma unroll
      for (int dk = 0; dk < NDK; ++dk) qf[dk] = *(const bf16x8*)(qp + dk * 16); }
    float m = NEG, l = 0.f;
    f32x16 o[4];
#pragma unroll
    for (int i = 0; i < 4; ++i)
#pragma unroll
        for (int r = 0; r < 16; ++r) o[i][r] = 0.f;
    u32x4 kr0, kr1, vr0, vr1;
    const int idA = tid, idB = tid + 512;
    const bf16_t* kg0 = QKV + (tokbase + (idA >> 4)) * QKVW + kcol + (idA & 15) * 8;
    const bf16_t* kg1 = QKV + (tokbase + (idB >> 4)) * QKVW + kcol + (idB & 15) * 8;
    const bf16_t* vg0 = VTb + (size_t)(idA >> 3) * SEQ + (idA & 7) * 8;
    const bf16_t* vg1 = VTb + (size_t)(idB >> 3) * SEQ + (idB & 7) * 8;
    const int kl0 = (idA >> 4) * KP + (idA & 15) * 16, kl1 = (idB >> 4) * KP + (idB & 15) * 16;
    const int vl0 = VRING + (idA >> 3) * VP + ((idA & 7) >> 1) * 32 + (idA & 1) * 8, vl1 = VRING + (idB >> 3) * VP + ((idB & 7) >> 1) * 32 + (idB & 1) * 8;
#define TILE_AT(i) (MODE ? tl[(i)] : (i))
#define GLOAD(K0, K1, V0, V1, kvt) do { const size_t ko_ = (size_t)(kvt) * 64 * QKVW; const int vo_ = (kvt) * 64; \
        K0 = *(const u32x4*)(kg0 + ko_); K1 = *(const u32x4*)(kg1 + ko_); V0 = *(const u32x4*)(vg0 + vo_); V1 = *(const u32x4*)(vg1 + vo_); } while (0)
#define LSTORE(K0, K1, V0, V1, kso, vso) do { LAS unsigned char* kb_ = lds + (kso); LAS unsigned char* vb_ = lds + (vso); \
        *(LAS u32x4*)(kb_ + kl0) = K0; *(LAS u32x4*)(kb_ + kl1) = K1; \
        *(LAS u32x2*)(vb_ + vl0) = (u32x2){V0.x, V0.y}; *(LAS u32x2*)(vb_ + vl0 + 16) = (u32x2){V0.z, V0.w}; \
        *(LAS u32x2*)(vb_ + vl1) = (u32x2){V1.x, V1.y}; *(LAS u32x2*)(vb_ + vl1 + 16) = (u32x2){V1.z, V1.w}; } while (0)
#define TILE_BARRIER() do { asm volatile("s_waitcnt lgkmcnt(0)" ::: "memory"); __builtin_amdgcn_s_barrier(); asm volatile("" ::: "memory"); } while (0)
#define MX3(a, b, c) __builtin_fmaxf(__builtin_fmaxf((a), (b)), (c))
#define SCHED_FENCE() __builtin_amdgcn_sched_barrier(0)
#define QK_TILE(kvt, kslot) do { \
        const int kv0 = (kvt) * 64; const int qlo = q0 + slab * 32; bool needmask; lval = true; \
        if (MODE == 0 || ((kvt) >> 2) == qb) { act = kv0 <= qlo + 31; needmask = kv0 + 63 > qlo; } \
        else { lval = (mymask >> ((kvt) >> 2)) & 1u; act = __any(lval); needmask = false; } \
        if (act) { \
            const LAS unsigned char* ka = lds + (kslot) + r32 * KP + (koff + hi * 8) * 2; \
            const f32x16 zz = {0.f, 0.f, 0.f, 0.f, 0.f, 0.f, 0.f, 0.f, 0.f, 0.f, 0.f, 0.f, 0.f, 0.f, 0.f, 0.f}; \
            bf16x8 kf[4]; \
            _Pragma("unroll") for (int d0 = 0; d0 < NDK; d0 += 4) { \
                _Pragma("unroll") for (int dk = 0; dk < 4; ++dk) kf[dk] = *(const LAS bf16x8*)(ka + (d0 + dk) * 32); \
                SCHED_FENCE(); \
                if (d0 == 0) p0 = __builtin_amdgcn_mfma_f32_32x32x16_bf16(kf[0], qf[0], zz, 0, 0, 0); else p0 = __builtin_amdgcn_mfma_f32_32x32x16_bf16(kf[0], qf[d0], p0, 0, 0, 0); \
                _Pragma("unroll") for (int dk = 1; dk < 4; ++dk) p0 = __builtin_amdgcn_mfma_f32_32x32x16_bf16(kf[dk], qf[d0 + dk], p0, 0, 0, 0); \
                SCHED_FENCE(); } \
            _Pragma("unroll") for (int d0 = 0; d0 < NDK; d0 += 4) { \
                _Pragma("unroll") for (int dk = 0; dk < 4; ++dk) kf[dk] = *(const LAS bf16x8*)(ka + 32 * KP + (d0 + dk) * 32); \
                SCHED_FENCE(); \
                if (d0 == 0) p1 = __builtin_amdgcn_mfma_f32_32x32x16_bf16(kf[0], qf[0], zz, 0, 0, 0); else p1 = __builtin_amdgcn_mfma_f32_32x32x16_bf16(kf[0], qf[d0], p1, 0, 0, 0); \
                _Pragma("unroll") for (int dk = 1; dk < 4; ++dk) p1 = __builtin_amdgcn_mfma_f32_32x32x16_bf16(kf[dk], qf[d0 + dk], p1, 0, 0, 0); \
                SCHED_FENCE(); } \
            SCHED_FENCE(); \
            if (needmask) { \
                asm volatile("" ::: "memory"); \
                _Pragma("unroll") for (int r = 0; r < 16; ++r) { const int kv = kv0 + crow(r, hi); if (kv > qpos) p0[r] = NEG; if (kv + 32 > qpos) p1[r] = NEG; } \
            } \
        } } while (0)
#define SOFTMAX_HALF(P, PA, PB) do { \
            float mx = MX3(P[0], P[1], P[2]); mx = MX3(mx, P[3], P[4]); mx = MX3(mx, P[5], P[6]); mx = MX3(mx, P[7], P[8]); \
            mx = MX3(mx, P[9], P[10]); mx = MX3(mx, P[11], P[12]); mx = MX3(mx, P[13], P[14]); mx = __builtin_fmaxf(mx, P[15]); \
            { auto rr_ = __builtin_amdgcn_permlane32_swap(__float_as_uint(mx), __float_as_uint(mx), false, false); mx = __builtin_fmaxf(__uint_as_float(rr_[0]), __uint_as_float(rr_[1])); } \
            if (MODE == 1 && !lval) mx = NEG; \
            const float mn = __builtin_fmaxf(m, mx); \
            if (__any(mn > m + 8.0f)) { const float alpha = __builtin_amdgcn_exp2f(m - mn); m = mn; l *= alpha; \
                _Pragma("unroll") for (int bl = 0; bl < 4; ++bl) o[bl] = o[bl] * alpha; } \
            const float ms = (MODE == 1 && !lval) ? 1e30f : m; \
            f32x2 s2 = {0.f, 0.f}; \
            _Pragma("unroll") for (int r = 0; r < 16; r += 2) { f32x2 t = {P[r], P[r + 1]}; t = t - (f32x2){ms, ms}; t.x = __builtin_amdgcn_exp2f(t.x); t.y = __builtin_amdgcn_exp2f(t.y); s2 = s2 + t; P[r] = t.x; P[r + 1] = t.y; } \
            l += s2.x + s2.y; \
            PA = pack8(P, 0); PB = pack8(P, 8); \
        } while (0)
#define SOFTMAX_FULL(P, Q, PA0, PB0, PA1, PB1) do { \
            float mx = MX3(P[0], P[1], P[2]); mx = MX3(mx, P[3], P[4]); mx = MX3(mx, P[5], P[6]); mx = MX3(mx, P[7], P[8]); \
            mx = MX3(mx, P[9], P[10]); mx = MX3(mx, P[11], P[12]); mx = MX3(mx, P[13], P[14]); mx = MX3(mx, P[15], Q[0]); \
            mx = MX3(mx, Q[1], Q[2]); mx = MX3(mx, Q[3], Q[4]); mx = MX3(mx, Q[5], Q[6]); mx = MX3(mx, Q[7], Q[8]); \
            mx = MX3(mx, Q[9], Q[10]); mx = MX3(mx, Q[11], Q[12]); mx = MX3(mx, Q[13], Q[14]); mx = __builtin_fmaxf(mx, Q[15]); \
            { auto rr_ = __builtin_amdgcn_permlane32_swap(__float_as_uint(mx), __float_as_uint(mx), false, false); mx = __builtin_fmaxf(__uint_as_float(rr_[0]), __uint_as_float(rr_[1])); } \
            if (MODE == 1 && !lval) mx = NEG; \
            const float mn = __builtin_fmaxf(m, mx); \
            if (__any(mn > m + 8.0f)) { const float alpha = __builtin_amdgcn_exp2f(m - mn); m = mn; l *= alpha; \
                _Pragma("unroll") for (int bl = 0; bl < 4; ++bl) o[bl] = o[bl] * alpha; } \
            const float ms = (MODE == 1 && !lval) ? 1e30f : m; \
            f32x2 s2 = {0.f, 0.f}; \
            _Pragma("unroll") for (int r = 0; r < 16; r += 2) { f32x2 t = {P[r], P[r + 1]}; t = t - (f32x2){ms, ms}; t.x = __builtin_amdgcn_exp2f(t.x); t.y = __builtin_amdgcn_exp2f(t.y); s2 = s2 + t; P[r] = t.x; P[r + 1] = t.y; } \
            PA0 = pack8(P, 0); PB0 = pack8(P, 8); \
            _Pragma("unroll") for (int r = 0; r < 16; r += 2) { f32x2 t = {Q[r], Q[r + 1]}; t = t - (f32x2){ms, ms}; t.x = __builtin_amdgcn_exp2f(t.x); t.y = __builtin_amdgcn_exp2f(t.y); s2 = s2 + t; Q[r] = t.x; Q[r + 1] = t.y; } \
            l += s2.x + s2.y; \
            PA1 = pack8(Q, 0); PB1 = pack8(Q, 8); \
        } while (0)
#define PV_HALF(vso, J0, PA, PB) do { \
            const LAS unsigned char* va = lds + (vso) + VRING + r32 * VP + hi * 16; bf16x8 vf[4]; \
            _Pragma("unroll") for (int b0 = 0; b0 < 4; b0 += 2) { \
                _Pragma("unroll") for (int bl = 0; bl < 2; ++bl) { vf[2 * bl] = *(const LAS bf16x8*)(va + (b0 + bl) * 32 * VP + (J0) * 32); vf[2 * bl + 1] = *(const LAS bf16x8*)(va + (b0 + bl) * 32 * VP + (J0) * 32 + 32); } \
                SCHED_FENCE(); \
                _Pragma("unroll") for (int bl = 0; bl < 2; ++bl) o[b0 + bl] = __builtin_amdgcn_mfma_f32_32x32x16_bf16(vf[2 * bl], PA, o[b0 + bl], 0, 0, 0); \
                _Pragma("unroll") for (int bl = 0; bl < 2; ++bl) o[b0 + bl] = __builtin_amdgcn_mfma_f32_32x32x16_bf16(vf[2 * bl + 1], PB, o[b0 + bl], 0, 0, 0); \
                SCHED_FENCE(); } \
        } while (0)
    const bool trailing = wid >= 4;
    bf16x8 pa0, pb0, pa1, pb1; bool actp = false; int vsp = 0;
#define STEP_LEAD(kvt, kslot, vso) do { f32x16 p0, p1; bool act, lval; \
            QK_TILE(kvt, kslot); \
            if (act) { SOFTMAX_HALF(p0, pa0, pb0); PV_HALF(vso, 0, pa0, pb0); SOFTMAX_HALF(p1, pa1, pb1); PV_HALF(vso, 2, pa1, pb1); } \
        } while (0)
#define STEP_TRAIL(kvt, kslot, vso) do { f32x16 p0, p1; bool act, lval; \
            if (actp) { PV_HALF(vsp, 0, pa0, pb0); PV_HALF(vsp, 2, pa1, pb1); } \
            QK_TILE(kvt, kslot); \
            if (act) { SOFTMAX_FULL(p0, p1, pa0, pb0, pa1, pb1); } \
            actp = act; vsp = (vso); \
        } while (0)
#define TILE_LOOP(STEP) do { \
    int vso = 0, kso = 0; \
    _Pragma("unroll 1") \
    for (int i = 0; i < ntiles; ++i) { \
          const int kvt = TILE_AT(i); \
          LSTORE(kr0, kr1, vr0, vr1, kso, vso); \
          TILE_BARRIER(); \
          GLOAD(kr0, kr1, vr0, vr1, TILE_AT(i + 1 < ntiles ? i + 1 : ntiles - 1)); \
          STEP(kvt, kso, vso); \
          kso ^= KBYTES; vso = (vso == 2 * VBYTES) ? 0 : vso + VBYTES; \
    } } while (0)
    GLOAD(kr0, kr1, vr0, vr1, TILE_AT(0));
    if (trailing) {
        TILE_LOOP(STEP_TRAIL);
        if (actp) { PV_HALF(vsp, 0, pa0, pb0); PV_HALF(vsp, 2, pa1, pb1); }
    } else {
        TILE_LOOP(STEP_LEAD);
    }
#undef TILE_LOOP
#undef STEP_LEAD
#undef STEP_TRAIL
#undef PV_HALF
#undef SOFTMAX_HALF
#undef SOFTMAX_FULL
#undef QK_TILE
#undef SCHED_FENCE
#undef MX3
#undef TILE_BARRIER
#undef TILE_AT
#undef GLOAD
#undef LSTORE
    l += __shfl_xor(l, 32);
    const float inv = 1.0f / l;
    if (MODE == 1) {
        __syncthreads();
        LAS unsigned char* stg = lds + wid * OSTG_BYTES;
        { LAS unsigned char* wp = stg + r32 * OSTG_PITCH + 8 * hi;
#pragma unroll
          for (int bl = 0; bl < 4; ++bl)
#pragma unroll
            for (int g = 0; g < 4; ++g) {
                u32x2 w; w.x = pk2(o[bl][4 * g] * inv, o[bl][4 * g + 1] * inv); w.y = pk2(o[bl][4 * g + 2] * inv, o[bl][4 * g + 3] * inv);
                *(LAS u32x2*)(wp + (bl * 32 + 8 * g) * 2) = w;
            } }
        asm volatile("s_waitcnt lgkmcnt(0)" ::: "memory");
        OSTG_FLUSH(stg, Y + (tokbase + q0 + slab * 32) * 1024 + h * 128);
        __syncthreads();
    } else {
        __syncthreads();
        LAS float* cb = (LAS float*)lds + (slab * 32 + r32) * 132 + 4 * hi;
        if (cmap == 1) {
#pragma unroll
            for (int bl = 0; bl < 4; ++bl)
#pragma unroll
                for (int g = 0; g < 4; ++g)
                    *(LAS f32x4*)(cb + bl * 32 + 8 * g) = (f32x4){o[bl][4 * g] * inv, o[bl][4 * g + 1] * inv, o[bl][4 * g + 2] * inv, o[bl][4 * g + 3] * inv};
        }
        __syncthreads();
        if (cmap == 0) {
            float ss = 0.f;
#pragma unroll
            for (int bl = 0; bl < 4; ++bl)
#pragma unroll
                for (int g = 0; g < 4; ++g) {
                    const f32x4 o2 = *(const LAS f32x4*)(cb + bl * 32 + 8 * g);
#pragma unroll
                    for (int e = 0; e < 4; ++e) { const float v = o[bl][4 * g + e] * inv - lam * o2[e]; o[bl][4 * g + e] = v; ss += v * v; }
                }
            ss += __shfl_xor(ss, 32);
            const float rs = rsqrtf(ss * (1.0f / 128.0f) + 1e-5f) * oscale;
            LAS unsigned char* stg = lds + 67584 + slab * OSTG_BYTES;
            { LAS unsigned char* wp = stg + r32 * OSTG_PITCH + 8 * hi;
#pragma unroll
              for (int bl = 0; bl < 4; ++bl)
#pragma unroll
                for (int g = 0; g < 4; ++g) {
                    const f32x4 gg = *(const f32x4*)(subg + bl * 32 + 8 * g + 4 * hi);
                    u32x2 w; w.x = pk2(o[bl][4 * g] * rs * gg[0], o[bl][4 * g + 1] * rs * gg[1]); w.y = pk2(o[bl][4 * g + 2] * rs * gg[2], o[bl][4 * g + 3] * rs * gg[3]);
                    *(LAS u32x2*)(wp + (bl * 32 + 8 * g) * 2) = w;
                } }
            asm volatile("s_waitcnt lgkmcnt(0)" ::: "memory");
            OSTG_FLUSH(stg, Y + (tokbase + q0 + slab * 32) * 1024 + h * 128);
        }
        __syncthreads();
    }
}
#undef LAS
}

#define LAS __attribute__((address_space(3)))
typedef unsigned short bf16;
typedef unsigned v4u __attribute__((ext_vector_type(4)));
typedef unsigned v2u __attribute__((ext_vector_type(2)));
typedef float f32x4 __attribute__((ext_vector_type(4)));
constexpr int NWAVES = 8, NTHR = 512;
constexpr int LDS_BYTES = 147456;
constexpr size_t MiB = 1u << 20;
constexpr size_t WS_BAR = 65536;
constexpr int LDS_BARST = 131072 + 64;
constexpr size_t WS_CSD = 1 * MiB, WS_CSM = WS_CSD + 4096 * 16 * 4, WS_KMEAN = 2 * MiB;
constexpr size_t WS_WGU1 = 4 * MiB, WS_WDN1 = 48 * MiB, WS_WGU2 = 70 * MiB, WS_WDN2 = 114 * MiB, WS_WIN = 136 * MiB, WS_WBD = 176 * MiB, WS_WBM = 180 * MiB, WS_WO = 184 * MiB;
constexpr size_t WS_H = 192 * MiB, WS_YZ = 256 * MiB, WS_R1 = 320 * MiB  , WS_GATE = WS_R1 + 192 * MiB;
constexpr size_t WS_VT = 640 * MiB, WS_MRG = 704 * MiB, WS_YA = 768 * MiB, WS_YB = 800 * MiB, WS_END = 832 * MiB;

struct Params { const float* in[20]; float* out; unsigned char* ws; int ph_lo, ph_hi; };
enum { I_X = 0, I_F1PRE, I_F1GU, I_F1DN, I_F1POST, I_MIXPRE, I_WIN, I_LQ1, I_LK1, I_LQ2, I_LK2, I_SUBG, I_WBD, I_WBM, I_WO, I_MIXPOST, I_F2PRE, I_F2GU, I_F2DN, I_F2POST };

__device__ __forceinline__ unsigned f2bf(float f) { unsigned u = __builtin_bit_cast(unsigned, f); return (u + 0x7fffu + ((u >> 16) & 1u)) >> 16; }
__device__ __forceinline__ unsigned pk2(float lo, float hi) { return f2bf(lo) | (f2bf(hi) << 16); }
__device__ __forceinline__ float wave_sum(float v) {
#pragma unroll
    for (int o = 1; o < 64; o <<= 1) v += __shfl_xor(v, o);
    return v;
}
struct ConvItem { const float* W; bf16* WT; int K, N, item, gu; };
__device__ __forceinline__ void conv_load(const ConvItem& c, float (&wv)[32], int lane) {
    const int nblk = c.N / 32, kb = c.item / nblk, nb = c.item % nblk, k0 = 64 * kb, n0 = 32 * nb;
    const float* p = c.W + (size_t)(k0 + (lane >> 5)) * c.N + n0 + (lane & 31);
#pragma unroll
    for (int i = 0; i < 32; ++i) wv[i] = __builtin_nontemporal_load(p + (size_t)(2 * i) * c.N);
}
__device__ __forceinline__ void conv_store(const ConvItem& c, const float (&wv)[32], LAS float* scr, int lane) {
    const int nblk = c.N / 32, kb = c.item / nblk, nb = c.item % nblk, k0 = 64 * kb, n0 = 32 * nb;
    int r0 = n0;
    if (c.gu) { const int up = n0 >= DFF ? 1 : 0, nn = n0 - up * DFF; r0 = (nn >> 7) * 256 + up * 128 + (nn & 127); }
#pragma unroll
    for (int i = 0; i < 32; ++i) scr[(2 * i + (lane >> 5)) * 33 + (lane & 31)] = wv[i];
    asm volatile("s_waitcnt lgkmcnt(0)" ::: "memory");
    const int cc = lane & 7;
#pragma unroll
    for (int j = 0; j < 4; ++j) { const int n = (lane >> 3) + 8 * j; const LAS float* sp = scr + (8 * cc) * 33 + n;
        v4u o; o.x = pk2(sp[0 * 33], sp[1 * 33]); o.y = pk2(sp[2 * 33], sp[3 * 33]); o.z = pk2(sp[4 * 33], sp[5 * 33]); o.w = pk2(sp[6 * 33], sp[7 * 33]);
        *(v4u*)(c.WT + (size_t)(r0 + n) * c.K + k0 + 8 * cc) = o; }
    asm volatile("s_waitcnt lgkmcnt(0)" ::: "memory");
}
typedef const __attribute__((address_space(4))) Params* KP;
__device__ __forceinline__ ConvItem conv_item(KP Pp, int layer, int it) {
    unsigned char* ws = Pp->ws;
    constexpr int I_GU = (DM / 64) * (2 * DFF / 32), I_DN = (DFF / 64) * (DM / 32), I_IN = (DM / 64) * (INW / 32), I_BR = (1024 / 64) * (DM / 32);
    const size_t lgu = (size_t)layer * DM * 2 * DFF, ldn = (size_t)layer * DFF * DM;
    int r = it;
    if (r < I_GU) return ConvItem{Pp->in[I_F1GU] + lgu, (bf16*)(ws + WS_WGU1), DM, 2 * DFF, r, 1}; r -= I_GU;
    if (r < I_GU) return ConvItem{Pp->in[I_F2GU] + lgu, (bf16*)(ws + WS_WGU2), DM, 2 * DFF, r, 1}; r -= I_GU;
    if (r < I_DN) return ConvItem{Pp->in[I_F1DN] + ldn, (bf16*)(ws + WS_WDN1), DFF, DM, r, 0}; r -= I_DN;
    if (r < I_DN) return ConvItem{Pp->in[I_F2DN] + ldn, (bf16*)(ws + WS_WDN2), DFF, DM, r, 0}; r -= I_DN;
    if (r < I_IN) return ConvItem{Pp->in[I_WIN] + (size_t)layer * DM * INW, (bf16*)(ws + WS_WIN), DM, INW, r, 0}; r -= I_IN;
    if (r < I_BR) return ConvItem{Pp->in[I_WBD] + (size_t)layer * 1024 * DM, (bf16*)(ws + WS_WBD), 1024, DM, r, 0}; r -= I_BR;
    if (r < I_BR) return ConvItem{Pp->in[I_WBM] + (size_t)layer * 1024 * DM, (bf16*)(ws + WS_WBM), 1024, DM, r, 0}; r -= I_BR;
    return ConvItem{Pp->in[I_WO] + (size_t)layer * DM * DM, (bf16*)(ws + WS_WO), DM, DM, r, 0};
}
__device__ __forceinline__ void convert_weights(KP Pp, int layer, LAS unsigned char* lds, int gw, int ngw, int wave, int lane) {
    LAS float* scr = (LAS float*)(lds + wave * 16384);
    constexpr int I_GU = (DM / 64) * (2 * DFF / 32), I_DN = (DFF / 64) * (DM / 32), I_IN = (DM / 64) * (INW / 32), I_BR = (1024 / 64) * (DM / 32), I_OUT = (DM / 64) * (DM / 32);
    constexpr int NIT = 2 * I_GU + 2 * I_DN + I_IN + 2 * I_BR + I_OUT;
    for (int it = gw; it < NIT; it += 2 * ngw) {
        const bool two = it + ngw < NIT;
        const ConvItem a = conv_item(Pp, layer, it), b = conv_item(Pp, layer, two ? it + ngw : it);
        float wa[32], wb[32];
        conv_load(a, wa, lane); conv_load(b, wb, lane);
        conv_store(a, wa, scr, lane);
        if (two) conv_store(b, wb, scr, lane);
    }
}
template <bool XIN_BF, bool XOUT_BF>
__device__ __forceinline__ void ew_rows(const void* xsrc, void* xdst, const bf16* y, float scale, const float* gpost, const float* gpre, bf16* hout, int gw, int ngw, int lane) {
    constexpr int NR = XIN_BF ? 4 : 2;
    for (int row0 = gw; row0 < TOK; row0 += NR * ngw) {
        v2u xb[XIN_BF ? NR : 1][8]; f32x4 xf[XIN_BF ? 1 : NR][8]; v2u yb[NR][8];
#pragma unroll
        for (int r = 0; r < NR; ++r) { const int row = (row0 + r * ngw < TOK) ? row0 + r * ngw : row0;
            if (XIN_BF) { const v2u* xr = (const v2u*)((const bf16*)xsrc + (size_t)row * DM) + lane;
#pragma unroll
                for (int j = 0; j < 8; ++j) xb[XIN_BF ? r : 0][j] = xr[64 * j];
            } else { const f32x4* xr = (const f32x4*)((const float*)xsrc + (size_t)row * DM) + lane;
#pragma unroll
                for (int j = 0; j < 8; ++j) xf[XIN_BF ? 0 : r][j] = xr[64 * j]; }
            if (y) { const v2u* yr = (const v2u*)(y + (size_t)row * DM) + lane;
#pragma unroll
                for (int j = 0; j < 8; ++j) yb[r][j] = yr[64 * j]; }
        }
        asm volatile("" ::: "memory");
#pragma unroll
        for (int r = 0; r < NR; ++r) { const int row = row0 + r * ngw; if (row >= TOK) break;
            f32x4 xv[8];
#pragma unroll
            for (int j = 0; j < 8; ++j) { if (XIN_BF) { const v2u w = xb[XIN_BF ? r : 0][j]; xv[j] = (f32x4){__uint_as_float(w.x << 16), __uint_as_float(w.x & 0xffff0000u), __uint_as_float(w.y << 16), __uint_as_float(w.y & 0xffff0000u)}; } else xv[j] = xf[XIN_BF ? 0 : r][j]; }
            if (y) {
                f32x4 yv[8]; float ss = 0.f;
#pragma unroll
                for (int j = 0; j < 8; ++j) { const v2u w = yb[r][j]; yv[j] = (f32x4){__uint_as_float(w.x << 16), __uint_as_float(w.x & 0xffff0000u), __uint_as_float(w.y << 16), __uint_as_float(w.y & 0xffff0000u)};
                    ss += (yv[j].x * yv[j].x + yv[j].y * yv[j].y) + (yv[j].z * yv[j].z + yv[j].w * yv[j].w); }
                const float rs = rsqrtf(wave_sum(ss) * (1.0f / DM) + 1e-6f) * scale;
#pragma unroll
                for (int j = 0; j < 8; ++j) { const f32x4 g = ((const f32x4*)gpost)[lane + 64 * j]; xv[j] = xv[j] + yv[j] * g * rs; }
                if (XOUT_BF) { v2u* xo = (v2u*)((bf16*)xdst + (size_t)row * DM) + lane;
#pragma unroll
                    for (int j = 0; j < 8; ++j) xo[64 * j] = (v2u){pk2(xv[j].x, xv[j].y), pk2(xv[j].z, xv[j].w)};
                } else { f32x4* xo = (f32x4*)((float*)xdst + (size_t)row * DM) + lane;
#pragma unroll
                    for (int j = 0; j < 8; ++j) xo[64 * j] = xv[j]; }
            }
            if (hout) {
                float s2 = 0.f;
#pragma unroll
                for (int j = 0; j < 8; ++j) s2 += (xv[j].x * xv[j].x + xv[j].y * xv[j].y) + (xv[j].z * xv[j].z + xv[j].w * xv[j].w);
                const float rs2 = rsqrtf(wave_sum(s2) * (1.0f / DM) + 1e-6f);
                v2u* ho = (v2u*)(hout + (size_t)row * DM) + lane;
#pragma unroll
                for (int j = 0; j < 8; ++j) { const f32x4 g = ((const f32x4*)gpre)[lane + 64 * j]; const f32x4 t = xv[j] * g * rs2; ho[64 * j] = (v2u){pk2(t.x, t.y), pk2(t.z, t.w)}; }
            }
        }
    }
}
__device__ __forceinline__ void build_tables(unsigned char* ws, int gtid, int ngt) {
    float* csd = (float*)(ws + WS_CSD); float* csm = (float*)(ws + WS_CSM);
    for (int i = gtid; i < SEQ * 24; i += ngt) {
        const int pos = i / 24, k = i % 24;
        const bool dd = k < 8; const int kk = dd ? k : k - 8;
        const float inv = __builtin_amdgcn_exp2f(-(float)kk * (dd ? 0.125f : 0.0625f) * 18.931568569324174f);
        const float ang = (float)pos * inv;
        float rev = ang * 0.15915494309189535f; rev = rev - __builtin_floorf(rev);
        const float c = __builtin_amdgcn_cosf(rev), sn = __builtin_amdgcn_sinf(rev);
        if (dd) { csd[pos * 16 + kk] = c; csd[pos * 16 + 8 + kk] = sn; } else { csm[pos * 32 + kk] = c; csm[pos * 32 + 16 + kk] = sn; }
    }
}
__device__ __forceinline__ void prep_phase(unsigned char* ws, LAS unsigned char* lds, int tid, int bx, int G) {
    const bf16* QKV = (const bf16*)(ws + WS_R1); bf16* VT = (bf16*)(ws + WS_VT); float* kmean = (float*)(ws + WS_KMEAN);
    for (int it = bx; it < 4096; it += G) {
        const int st = it & 63, hh = (it >> 6) & 7, b = (it >> 9) & 3, vt = it >> 11;
        const int s0 = st * 64, vcol = (vt ? 5120 : 2048) + hh * 128;
#pragma unroll
        for (int i = 0; i < 2; ++i) { const int id = tid + 512 * i, row = id >> 4, c = id & 15;
            const v4u w = *(const v4u*)(QKV + ((size_t)b * SEQ + s0 + row) * QKVW + vcol + c * 8);
            LAS unsigned* d = (LAS unsigned*)(lds + row * 260 + c * 16); d[0] = w.x; d[1] = w.y; d[2] = w.z; d[3] = w.w; }
        __syncthreads();
        { const int d = tid >> 2, sq = tid & 3; unsigned short e[16];
#pragma unroll
          for (int i = 0; i < 16; ++i) e[i] = *(const LAS unsigned short*)(lds + (16 * sq + i) * 260 + d * 2);
          v4u w0, w1;
          w0.x = e[0] | ((unsigned)e[1] << 16); w0.y = e[2] | ((unsigned)e[3] << 16); w0.z = e[4] | ((unsigned)e[5] << 16); w0.w = e[6] | ((unsigned)e[7] << 16);
          w1.x = e[8] | ((unsigned)e[9] << 16); w1.y = e[10] | ((unsigned)e[11] << 16); w1.z = e[12] | ((unsigned)e[13] << 16); w1.w = e[14] | ((unsigned)e[15] << 16);
          bf16* dst = VT + ((size_t)(vt * 32 + b * 8 + hh) * 128 + d) * SEQ + s0 + 16 * sq;
          *(v4u*)dst = w0; *(v4u*)(dst + 8) = w1; }
        __syncthreads();
    }
    for (int it = bx; it < 512; it += G) {
        const int blk = it & 15, hh = (it >> 4) & 7, b = it >> 7;
        const int dg = tid & 15, rg = tid >> 4;
        float a[8];
#pragma unroll
        for (int e = 0; e < 8; ++e) a[e] = 0.f;
#pragma unroll
        for (int i = 0; i < 8; ++i) { const v4u w = *(const v4u*)(QKV + ((size_t)b * SEQ + blk * 256 + rg + 32 * i) * QKVW + 4096 + hh * 128 + dg * 8);
            a[0] += __uint_as_float(w.x << 16); a[1] += __uint_as_float(w.x & 0xffff0000u); a[2] += __uint_as_float(w.y << 16); a[3] += __uint_as_float(w.y & 0xffff0000u);
            a[4] += __uint_as_float(w.z << 16); a[5] += __uint_as_float(w.z & 0xffff0000u); a[6] += __uint_as_float(w.w << 16); a[7] += __uint_as_float(w.w & 0xffff0000u); }
        LAS float* part = (LAS float*)lds;
#pragma unroll
        for (int e = 0; e < 8; ++e) part[rg * 128 + dg * 8 + e] = a[e];
        __syncthreads();
        if (tid < 128) { float s = 0.f;
#pragma unroll
            for (int r = 0; r < 32; ++r) s += part[r * 128 + tid];
            kmean[(size_t)((b * 8 + hh) * 16 + blk) * 128 + tid] = s * (1.0f / 256.0f); }
        __syncthreads();
    }
}
#define XB_TMO      128
#define XB_XCNT(j)  (256  + 64 * (j))
#define XB_XSUB(j)  (1280 + 64 * (j))
#define XB_XGEN(j)  (2304 + 64 * (j))
#define XB_TOP      3328
#define XB_TOPGEN   3392
#define XCD_BAR_WORDS 3456
#define XB_SPIN_CAP (1u << 18)

__device__ __forceinline__ unsigned xb_ld(unsigned* p)              { return __hip_atomic_load(p, __ATOMIC_RELAXED, __HIP_MEMORY_SCOPE_AGENT); }
__device__ __forceinline__ unsigned xb_add(unsigned* p, unsigned v) { return __hip_atomic_fetch_add(p, v, __ATOMIC_RELAXED, __HIP_MEMORY_SCOPE_AGENT); }
__device__ __forceinline__ unsigned xb_xcc_id() { return (unsigned)__builtin_amdgcn_s_getreg((3 << 11) | 20) & 0xFu; }
#define XB_SPIN(cond, bar) do { unsigned _sp = 0; while (cond) { __builtin_amdgcn_s_sleep(1); \
    if ((++_sp & 255u) == 0u) { if (xb_ld(&(bar)[XB_TMO])) break; if (_sp > XB_SPIN_CAP) { atomicAdd(&(bar)[XB_TMO], 1u); break; } } } } while (0)

struct XcdBarrier {
    unsigned* bar; unsigned x;
    volatile LAS unsigned* st;
};

__device__ __forceinline__ XcdBarrier xcd_barrier_post(unsigned* bar, volatile LAS unsigned* st) {
    XcdBarrier b; b.bar = bar; b.x = xb_xcc_id(); b.st = st;
    if (threadIdx.x == 0) (void)xb_add(&bar[XB_XCNT(b.x)], 1u);
    return b;
}
__device__ __forceinline__ void xcd_barrier_complete(unsigned* bar, unsigned x, unsigned& nloc, unsigned& nx) {
    const unsigned G = gridDim.x * gridDim.y * gridDim.z;
    unsigned sum, cnt, mine, sp = 0u;
    for (;;) {
        sum = 0u; cnt = 0u; mine = 0u;
#pragma unroll
        for (unsigned j = 0; j < 16; ++j) { const unsigned c = xb_ld(&bar[XB_XCNT(j)]); sum += c; cnt += (c > 0u) ? 1u : 0u; mine = (j == x) ? c : mine; }
        if (sum == G) break;
        __builtin_amdgcn_s_sleep(1);
        if ((++sp & 255u) == 0u) { if (xb_ld(&bar[XB_TMO])) break; if (sp > XB_SPIN_CAP) { atomicAdd(&bar[XB_TMO], 1u); break; } }
    }
    nloc = mine > 0u ? mine : 1u; nx = cnt > 0u ? cnt : 1u;
}

__device__ __forceinline__ void xcd_barrier(const XcdBarrier& b) {
    asm volatile("s_waitcnt vmcnt(0)" ::: "memory");
    __syncthreads();
    if (threadIdx.x == 0) {
        unsigned* bar = b.bar;
        __builtin_amdgcn_s_waitcnt(0);
        unsigned nloc = b.st[0], nx = b.st[1];
        if (nloc == 0u) { xcd_barrier_complete(bar, b.x, nloc, nx); b.st[0] = nloc; b.st[1] = nx; }
        const unsigned old = xb_add(&bar[XB_XSUB(b.x)], 1u);
        const unsigned gen = old / nloc;
        if (old + 1u == (gen + 1u) * nloc) {
            __builtin_amdgcn_fence(__ATOMIC_RELEASE, "agent");
            asm volatile("s_waitcnt vmcnt(0)" ::: "memory");
            const unsigned og = xb_add(&bar[XB_TOP], 1u);
            const unsigned tg = og / nx;
            if (og + 1u == (tg + 1u) * nx) xb_add(&bar[XB_TOPGEN], 1u);
            else XB_SPIN(xb_ld(&bar[XB_TOPGEN]) == tg, bar);
            __builtin_amdgcn_fence(__ATOMIC_ACQUIRE, "agent");
            xb_add(&bar[XB_XGEN(b.x)], 1u);
            asm volatile("s_waitcnt vmcnt(0)" ::: "memory");
        } else {
            XB_SPIN(xb_ld(&bar[XB_XGEN(b.x)]) == gen, bar);
            __builtin_amdgcn_fence(__ATOMIC_ACQUIRE, "agent");
            asm volatile("s_waitcnt vmcnt(0)" ::: "memory");
        }
    }
    __syncthreads();
}

__global__ void __launch_bounds__(NTHR, 2) fwd_kernel(Params P) {
    extern __shared__ __attribute__((aligned(16))) unsigned char lds_raw[];
    LAS unsigned char* lds = (LAS unsigned char*)lds_raw;
    cg::grid_group grid = cg::this_grid();
    if (threadIdx.x < 2) ((LAS unsigned*)(lds + LDS_BARST))[threadIdx.x] = 0u;
    __syncthreads();
    int ph_lo, ph_hi;
    { KP k0 = (KP)__builtin_amdgcn_kernarg_segment_ptr(); ph_lo = k0->ph_lo; ph_hi = k0->ph_hi; }
#pragma unroll 1
    for (int ph = ph_lo; ph < ph_hi; ++ph) {
        KP Pp = (KP)__builtin_amdgcn_kernarg_segment_ptr(); asm volatile("" : "+s"(Pp));
        int tid_ = threadIdx.x; asm volatile("" : "+v"(tid_));
        int G = gridDim.x, bx = blockIdx.x; asm volatile("" : "+s"(G), "+s"(bx));
        unsigned char* ws = Pp->ws;
        bf16* H = (bf16*)(ws + WS_H); bf16* YZ = (bf16*)(ws + WS_YZ); bf16* ACT = (bf16*)(ws + WS_R1); bf16* QKV = (bf16*)(ws + WS_R1); bf16* GATE = (bf16*)(ws + WS_GATE);
        bf16* VT = (bf16*)(ws + WS_VT); bf16* MRG = (bf16*)(ws + WS_MRG); bf16* YA = (bf16*)(ws + WS_YA); bf16* YB = (bf16*)(ws + WS_YB);

        const int tid = tid_, lane = tid & 63, wave = __builtin_amdgcn_readfirstlane(tid >> 6);
        const int gw = bx * NWAVES + wave, ngw = G * NWAVES;
        if (ph >= 1 && (ph - 1) % 12 == 4) continue;
        if (ph == 0) {
            if (bx == 0) for (int w = tid; w < XCD_BAR_WORDS; w += NTHR) ((unsigned*)(ws + WS_BAR))[w] = 0u;
            build_tables(ws, bx * NTHR + tid, G * NTHR);
            convert_weights(Pp, 0, lds, gw, ngw, wave, lane);
            ew_rows<false, false>(Pp->in[I_X], nullptr, nullptr, 0.f, nullptr, Pp->in[I_F1PRE], H, gw, ngw, lane);
        } else {
            const int l = (ph - 1) / 12, k = (ph - 1) % 12;
#ifndef NO_GU
            if (k == 0 || k == 9) {
                pg8::Gemm g{H, (const bf16*)(ws + (k == 0 ? WS_WGU1 : WS_WGU2)), TOK, 2 * DFF, DM};
                pg8::StaticOrderT<2 * DFF> S; S.init(TOK, 2 * DFF, G, bx);
                pg8::EpiSwiglu E{ACT, DFF};
                pg8::gemm_phase<pg8::EpiSwiglu, pg8::StaticOrderT<2 * DFF>, true, true>(lds, g, S, E);
            } else
#endif
#ifndef NO_ST
            if (k == 1 || k == 10) {
                pg8::Gemm g{ACT, (const bf16*)(ws + (k == 1 ? WS_WDN1 : WS_WDN2)), TOK, DM, DFF};
                pg8::StaticOrderT<DM> S; S.init(TOK, DM, G, bx);
                pg8::EpiStore E{YZ, DM};
                pg8::gemm_phase<pg8::EpiStore, pg8::StaticOrderT<DM>, true, true>(lds, g, S, E);
            } else if (k == 7) {
                pg8::Gemm g{MRG, (const bf16*)(ws + WS_WO), TOK, DM, DM};
                pg8::StaticOrderT<DM> S; S.init(TOK, DM, G, bx);
                pg8::EpiStore E{YZ, DM};
                pg8::gemm_phase<pg8::EpiStore, pg8::StaticOrderT<DM>, true, true>(lds, g, S, E);
            } else
#endif
#ifndef NO_EW
            if (k == 2 || k == 8 || k == 11) {
                const float* gpost = Pp->in[k == 2 ? I_F1POST : k == 8 ? I_MIXPOST : I_F2POST] + l * DM;
                const float* gpre = k == 2 ? Pp->in[I_MIXPRE] + l * DM : k == 8 ? Pp->in[I_F2PRE] + l * DM : Pp->in[I_F1PRE] + (l + 1) * DM;
                const bool last = (k == 11 && l + 1 == NL);
                if (k == 2 && bx == 0) for (int w = tid; w < NB * 8 * 16 * 128; w += NTHR) ((float*)(ws + WS_KMEAN))[w] = 0.f;
                const float sc = k == 8 ? 1.0f : 0.5f;
                bf16* XB = (bf16*)Pp->out; float* XF = (float*)(ws + WS_GATE);
                if (k == 2 && l == 0) ew_rows<false, true>(Pp->in[I_X], XB, YZ, sc, gpost, gpre, H, gw, ngw, lane);
                else if (last) ew_rows<false, false>(XF, Pp->out, YZ, sc, gpost, gpre, nullptr, gw, ngw, lane);
                else if (k == 8 && l + 1 == NL) ew_rows<true, false>(XB, XF, YZ, sc, gpost, gpre, H, gw, ngw, lane);
                else ew_rows<true, true>(XB, XB, YZ, sc, gpost, gpre, H, gw, ngw, lane);
                if (k == 11 && !last) convert_weights(Pp, l + 1, lds, gw, ngw, wave, lane);
            } else
#endif
#ifndef NO_PROJ
            if (k == 3) {
                pg8::Gemm g{H, (const bf16*)(ws + WS_WIN), TOK, INW, DM};
                pg8::StaticOrderT<INW> S; S.init(TOK, INW, G, bx);
                pg8::EpiProj E{QKV, GATE, (const float*)(ws + WS_CSD), (const float*)(ws + WS_CSM), VT, (float*)(ws + WS_KMEAN)};
                pg8::gemm_phase<pg8::EpiProj, pg8::StaticOrderT<INW>, true, true>(lds, g, S, E);
            } else
#endif
#ifndef NO_PREP
            if (k == 4) {
                prep_phase(ws, lds, tid, bx, G);
            } else
#endif
#ifndef NO_ATT
            if (k == 5) {
                const float linit = l == 0 ? 0.2f : 0.35550906759f;
                const float d1 = wave_sum(Pp->in[I_LQ1][l * 64 + lane] * Pp->in[I_LK1][l * 64 + lane]);
                const float d2 = wave_sum(Pp->in[I_LQ2][l * 64 + lane] * Pp->in[I_LK2][l * 64 + lane]);
                const float lam = __builtin_amdgcn_exp2f(d1 * LOG2E) - __builtin_amdgcn_exp2f(d2 * LOG2E) + linit;
                const int vcu = (G % 8 == 0) ? (bx % 8) * (G / 8) + bx / 8 : bx;
#ifndef REP_ATT
#define REP_ATT 1
#endif
                for (int rep = 0; rep < REP_ATT; ++rep)
                for (int u = vcu; u < 256; u += G) {
                    const int bh = u >> 3, s = u & 7, b = bh >> 3, hh = bh & 7;
                    att::attn_unit<1>(lds, QKV, VT, (const float*)(ws + WS_KMEAN), YB, b, hh, s, 0.f, 0.f, nullptr);
                    att::attn_unit<1>(lds, QKV, VT, (const float*)(ws + WS_KMEAN), YB, b, hh, 15 - s, 0.f, 0.f, nullptr);
#pragma unroll 1
                    for (int i = 0; i < 4; ++i) {
                        const int qb = i == 0 ? s : i == 1 ? 15 - s : i == 2 ? 16 + s : 31 - s;
                        att::attn_unit<0>(lds, QKV, VT, nullptr, YA, b, hh, qb, lam, 1.0f - linit, Pp->in[I_SUBG] + l * 128);
                    }
                }
            } else
#endif
#ifndef NO_BR
            if (k == 6) {
                static_assert(WS_YB == WS_YA + (size_t)TOK * 1024 * 2 && WS_WBM == WS_WBD + (size_t)DM * 1024 * 2, "stacked branch operands must be adjacent");
                pg8::BranchOrder S; S.init(G, bx);
                pg8::Gemm g{YA, (const bf16*)(ws + WS_WBD), 2 * TOK, 2 * DM, 1024}; pg8::EpiGate2 E{MRG, GATE};
                pg8::gemm_phase<pg8::EpiGate2, pg8::BranchOrder, true, true>(lds, g, S, E);
            } else
#endif
            {}
        }
        if (ph + 1 < ph_hi) {
            if (ph == ph_lo) { grid.sync(); (void)xcd_barrier_post((unsigned*)(ws + WS_BAR), (volatile LAS unsigned*)(lds + LDS_BARST)); }
            else { XcdBarrier xb_; xb_.bar = (unsigned*)(ws + WS_BAR); xb_.x = xb_xcc_id(); xb_.st = (volatile LAS unsigned*)(lds + LDS_BARST); xcd_barrier(xb_); }
        }
    }
}

constexpr int N_PHASES = 1 + 12 * NL;
extern "C" void kernel_launch(void* const* d_in, const int* in_sizes, int n_in, void* d_out, int out_size, void* d_ws, size_t ws_size, hipStream_t stream) {
    static int grid = 0;
    if (grid == 0) {
        if (n_in != 20 || in_sizes[0] != TOK * DM || out_size != TOK * DM || ws_size < WS_END) { fprintf(stderr, "kernel_launch: unexpected shapes (n_in %d, in0 %d, out %d, ws %zu; need ws >= %zu)\n", n_in, n_in > 0 ? in_sizes[0] : -1, out_size, ws_size, (size_t)WS_END); grid = -1; return; }
        int dev = 0, cus = 0, per_cu = 0;
        (void)hipGetDevice(&dev); (void)hipDeviceGetAttribute(&cus, hipDeviceAttributeMultiprocessorCount, dev);
        if (hipFuncSetAttribute((const void*)fwd_kernel, hipFuncAttributeMaxDynamicSharedMemorySize, LDS_BYTES) != hipSuccess) { fprintf(stderr, "kernel_launch: hipFuncSetAttribute failed\n"); }
        if (hipOccupancyMaxActiveBlocksPerMultiprocessor(&per_cu, (const void*)fwd_kernel, NTHR, LDS_BYTES) != hipSuccess || per_cu < 1) { fprintf(stderr, "kernel_launch: occupancy query gave %d\n", per_cu); per_cu = 1; }
        (void)hipGetLastError();
        if (per_cu > 1) per_cu = 1;
        grid = cus * per_cu;
    }
    if (grid < 0) return;
    Params p{};
    for (int i = 0; i < 20; ++i) p.in[i] = (const float*)d_in[i];
    p.out = (float*)d_out; p.ws = (unsigned char*)d_ws; p.ph_lo = 0; p.ph_hi = N_PHASES;
    void* args[] = {&p};
    const hipError_t e = hipLaunchCooperativeKernel((const void*)fwd_kernel, dim3(grid), dim3(NTHR), args, LDS_BYTES, stream);
    if (e != hipSuccess) fprintf(stderr, "kernel_launch: cooperative launch failed: %s (grid %d)\n", hipGetErrorString(e), grid);
}
```
